# Optimizing an MI355X kernel written in HIP

```python
import math
import jax, jax.numpy as jnp
from jax import lax
import numpy as np


D_MODEL = 1024
BATCH = 2
SEQ = 8192
DEPTH = 2

HEAD_DIM = 64
RET_DIM = D_MODEL // 4
RET_HEADS = RET_DIM // HEAD_DIM
RET_CHUNK = 128
SSD_DIM = D_MODEL // 2
SSD_HEADS = SSD_DIM // HEAD_DIM
SSD_GROUPS = 2
SSD_STATE = 64
SSD_CONV = 4
SSD_CHUNK = 128
SSD_CONV_DIM = SSD_DIM + 2 * SSD_GROUPS * SSD_STATE
SWA_DIM = D_MODEL // 4
SWA_HEADS = SWA_DIM // HEAD_DIM
SWA_KV_HEADS = 2
SWA_KV_DIM = SWA_KV_HEADS * HEAD_DIM
WINDOW = 128
REL_BUCKETS = 32
REL_MAX_DIST = WINDOW
MIX_DIM = RET_DIM + SSD_DIM + SWA_DIM
IN_SIZES = (RET_DIM, RET_DIM, RET_DIM, RET_DIM,
            SSD_DIM, SSD_CONV_DIM, SSD_HEADS,
            SWA_DIM, SWA_KV_DIM, SWA_KV_DIM)
IN_DIM = sum(IN_SIZES)
D_FF = 2816
N_EXPERTS = 8
TOP_K = 2
D_FF_EXPERT = 3584
N_DENSE = (DEPTH + 1) // 2
N_MOE = DEPTH // 2
DEEPNORM_ALPHA = (2 * DEPTH) ** 0.25
DEEPNORM_BETA = (8 * DEPTH) ** -0.25
LN_EPS = 1e-5

kernel_name = 'hybrid_ret_ssd_swa_moe_deepnorm_adaln'


def _layer_norm(x, g, b):
    xf = x.astype(jnp.float32)
    mu = jnp.mean(xf, -1, keepdims=True)
    var = jnp.mean(jnp.square(xf - mu), -1, keepdims=True)
    return ((xf - mu) * lax.rsqrt(var + LN_EPS) * g + b).astype(x.dtype)


def _rotary(t, pos):
    half = t.shape[-1] // 2
    inv = jnp.exp(-math.log(10000.0) * jnp.arange(half, dtype=jnp.float32) / half)
    ang = pos.astype(jnp.float32)[..., None] * inv
    cos = jnp.cos(ang)[:, :, None, :]
    sin = jnp.sin(ang)[:, :, None, :]
    t1, t2 = t[..., :half], t[..., half:]
    return jnp.concatenate([t1 * cos - t2 * sin, t1 * sin + t2 * cos], -1).astype(t.dtype)


def _retention(q, k, v, g, pos):
    Bn, L, _ = q.shape
    H, d, C = RET_HEADS, HEAD_DIM, RET_CHUNK
    N = L // C
    dt = q.dtype
    q = _rotary(q.reshape(Bn, L, H, d), pos)
    k = _rotary(k.reshape(Bn, L, H, d), pos) * (d ** -0.5)
    v = v.reshape(Bn, L, H, d)
    log_gamma = jnp.log(1.0 - 2.0 ** (-5.0 - jnp.arange(H, dtype=jnp.float32)))
    idx = jnp.arange(C, dtype=jnp.float32)
    diff = idx[:, None] - idx[None, :]
    decay_in = jnp.where(diff >= 0, jnp.exp(log_gamma[:, None, None] * jnp.maximum(diff, 0.0)), 0.0).astype(dt)
    decay_q = jnp.exp(log_gamma[:, None] * (idx + 1.0)).astype(dt)
    decay_k = jnp.exp(log_gamma[:, None] * (C - 1.0 - idx)).astype(dt)
    decay_chunk = jnp.exp(log_gamma * C).astype(dt)
    qc = q.reshape(Bn, N, C, H, d)
    kc = k.reshape(Bn, N, C, H, d)
    vc = v.reshape(Bn, N, C, H, d)
    scores = jnp.einsum('bnihd,bnjhd->bnhij', qc, kc) * decay_in
    inner = jnp.einsum('bnhij,bnjhe->bnihe', scores, vc)
    chunk_kv = jnp.einsum('bnjhd,hj,bnjhe->nbhde', kc, decay_k, vc)

    def step(state, kv):
        return decay_chunk[None, :, None, None] * state + kv, state

    _, prev = lax.scan(step, jnp.zeros(chunk_kv.shape[1:], chunk_kv.dtype), chunk_kv)
    cross = jnp.einsum('bnihd,hi,nbhde->bnihe', qc, decay_q, prev)
    o = (inner + cross).reshape(Bn, L, H, d).astype(jnp.float32)
    mu = jnp.mean(o, -1, keepdims=True)
    var = jnp.mean(jnp.square(o - mu), -1, keepdims=True)
    o = ((o - mu) * lax.rsqrt(var + LN_EPS)).astype(dt).reshape(Bn, L, RET_DIM)
    return jax.nn.silu(g) * o


def _ssd(z, xbc, dt_raw, conv_w, conv_b, dt_bias, a_log, d_skip, norm_w):
    Bn, L, _ = z.shape
    G, R, P, NS, C = SSD_GROUPS, SSD_HEADS // SSD_GROUPS, HEAD_DIM, SSD_STATE, SSD_CHUNK
    NC = L // C
    xbc = lax.conv_general_dilated(xbc, conv_w[:, None, :], window_strides=(1,),
                                   padding=[(SSD_CONV - 1, 0)],
                                   dimension_numbers=('NWC', 'WIO', 'NWC'),
                                   feature_group_count=SSD_CONV_DIM) + conv_b
    xbc = jax.nn.silu(xbc)
    xs, Bm, Cm = jnp.split(xbc, [SSD_DIM, SSD_DIM + G * NS], -1)
    dt = jax.nn.softplus(dt_raw.astype(jnp.float32) + dt_bias)
    a = -jnp.exp(a_log.astype(jnp.float32)) * dt
    x = xs.reshape(Bn, NC, C, G, R, P)
    xdt = x * dt.reshape(Bn, NC, C, G, R, 1).astype(x.dtype)
    Bm = Bm.reshape(Bn, NC, C, G, NS)
    Cm = Cm.reshape(Bn, NC, C, G, NS)
    a_cs = jnp.cumsum(a.reshape(Bn, NC, C, G, R), axis=2).transpose(0, 1, 3, 4, 2)
    causal = jnp.tril(jnp.ones((C, C), dtype=bool))
    seg = a_cs[..., :, None] - a_cs[..., None, :]
    lmat = jnp.exp(jnp.where(causal, seg, -jnp.inf))
    cb = jnp.einsum('bclgn,bcsgn->bcgls', Cm, Bm)
    y_diag = jnp.einsum('bcgls,bcgrls,bcsgrp->bclgrp', cb, lmat, xdt)
    decay_states = jnp.exp(a_cs[..., -1:] - a_cs)
    states = jnp.einsum('bclgn,bcgrl,bclgrp->cbgrpn', Bm, decay_states, xdt).astype(jnp.float32)
    chunk_decay = jnp.exp(a_cs[..., -1]).transpose(1, 0, 2, 3)

    def step(S, inp):
        dec, st = inp
        return dec[..., None, None] * S + st, S

    _, prev = lax.scan(step, jnp.zeros(states.shape[1:], jnp.float32), (chunk_decay, states))
    y_off = jnp.einsum('bclgn,cbgrpn,bcgrl->bclgrp', Cm, prev, jnp.exp(a_cs))
    y = y_diag + y_off + x * d_skip.reshape(G, R, 1)
    y = y.reshape(Bn, L, SSD_DIM).astype(z.dtype)
    h = (y * jax.nn.silu(z)).astype(jnp.float32).reshape(Bn, L, G, SSD_DIM // G)
    h = h * lax.rsqrt(jnp.mean(jnp.square(h), -1, keepdims=True) + LN_EPS)
    return (h.reshape(Bn, L, SSD_DIM) * norm_w).astype(z.dtype)


def _t5_bucket(dist):
    exact = REL_BUCKETS // 2
    df = jnp.maximum(dist, 1).astype(jnp.float32)
    large = exact + (jnp.log(df / exact) / math.log(REL_MAX_DIST / exact) * (REL_BUCKETS - exact)).astype(jnp.int32)
    large = jnp.minimum(large, REL_BUCKETS - 1)
    return jnp.where(dist < exact, dist, large)


def _swa(q, k, v, rel_bias, sinks):
    Bn, L, _ = q.shape
    W, HK, GQ, d = WINDOW, SWA_KV_HEADS, SWA_HEADS // SWA_KV_HEADS, HEAD_DIM
    NB = L // W
    qb = q.reshape(Bn, NB, W, HK, GQ, d)
    kb = k.reshape(Bn, NB, W, HK, d)
    vb = v.reshape(Bn, NB, W, HK, d)

    def band(t):
        prev = jnp.concatenate([jnp.zeros_like(t[:, :1]), t[:, :-1]], axis=1)
        return jnp.concatenate([prev, t], axis=2)

    kband, vband = band(kb), band(vb)
    qi = jnp.arange(W)[:, None]
    kj = jnp.arange(2 * W)[None, :]
    dist = qi + W - kj
    in_band = (dist >= 0) & (dist < W)
    kpos = jnp.arange(NB)[:, None, None] * W - W + kj[None]
    valid = in_band[None] & (kpos >= 0)
    bias = rel_bias[_t5_bucket(jnp.clip(dist, 0, W - 1))]
    bias = bias.transpose(2, 0, 1).reshape(HK, GQ, W, 2 * W).astype(jnp.float32)
    logits = jnp.einsum('bnikgd,bnjkd->bnkgij', qb, kband).astype(jnp.float32) * (d ** -0.5) + bias
    logits = jnp.where(valid[None, :, None, None], logits, -jnp.inf)
    sink = sinks.astype(jnp.float32).reshape(HK, GQ, 1)
    m = jnp.maximum(jnp.max(logits, -1), sink)
    p = jnp.exp(logits - m[..., None])
    denom = jnp.sum(p, -1) + jnp.exp(sink - m)
    o = jnp.einsum('bnkgij,bnjkd->bnikgd', (p / denom[..., None]).astype(v.dtype), vband)
    return o.reshape(Bn, L, SWA_DIM)


def _swiglu(h, wg, wu, wd):
    return (jax.nn.silu(h @ wg) * (h @ wu)) @ wd


def _moe(h, w_router, b_router, wg, wu, wd):
    Bn, L, D = h.shape
    t = h.reshape(-1, D)
    logits = (t @ w_router).astype(jnp.float32) + b_router
    top_v, top_i = lax.top_k(logits, TOP_K)
    top_w = jax.nn.softmax(top_v, -1)
    gates = jnp.sum(jax.nn.one_hot(top_i, N_EXPERTS, dtype=jnp.float32) * top_w[..., None], axis=1)
    out = jnp.zeros_like(t)
    for e in range(N_EXPERTS):
        out = out + gates[:, e:e + 1].astype(t.dtype) * _swiglu(t, wg[e], wu[e], wd[e])
    return out.reshape(Bn, L, D)


def setup_inputs(seed: int = 0) -> dict:
    key = jax.random.key(seed)
    ks = jax.random.split(key, 32)
    f32 = jnp.float32
    D = D_MODEL

    def nrm(k, shape, scale):
        return jax.random.normal(k, shape, f32) * scale

    x = nrm(ks[0], (BATCH, SEQ, D), 1.0)
    c = nrm(ks[1], (BATCH, D), 1.0)
    offsets = jax.random.randint(ks[2], (BATCH, 1), 0, 1024, dtype=jnp.int32)
    positions = offsets + jnp.arange(SEQ, dtype=jnp.int32)[None, :]
    rel_bias = nrm(ks[3], (REL_BUCKETS, SWA_HEADS), 0.5)
    w_ada = nrm(ks[4], (DEPTH, D, 6 * D), 0.1 * D ** -0.5)
    b_ada = nrm(ks[5], (DEPTH, 6 * D), 0.01)
    w_in = nrm(ks[6], (DEPTH, D, IN_DIM), D ** -0.5)
    w_out = nrm(ks[7], (DEPTH, MIX_DIM, D), DEEPNORM_BETA * MIX_DIM ** -0.5)
    conv_w = nrm(ks[8], (DEPTH, SSD_CONV, SSD_CONV_DIM), SSD_CONV ** -0.5)
    conv_b = nrm(ks[9], (DEPTH, SSD_CONV_DIM), 0.01)
    u = jax.random.uniform(ks[10], (DEPTH, SSD_HEADS), f32)
    dt0 = jnp.exp(u * (math.log(0.1) - math.log(0.001)) + math.log(0.001))
    dt_bias = dt0 + jnp.log(-jnp.expm1(-dt0))
    a_log = jnp.log(jax.random.uniform(ks[11], (DEPTH, SSD_HEADS), f32, 1.0, 16.0))
    d_skip = 1.0 + nrm(ks[12], (DEPTH, SSD_HEADS), 0.1)
    ssd_norm_w = 1.0 + nrm(ks[13], (DEPTH, SSD_DIM), 0.02)
    sinks = nrm(ks[14], (DEPTH, SWA_HEADS), 0.5)
    ln_g = 1.0 + nrm(ks[15], (DEPTH, 2, D), 0.02)
    ln_b = nrm(ks[16], (DEPTH, 2, D), 0.02)
    ffn_w_gate = nrm(ks[17], (N_DENSE, D, D_FF), D ** -0.5)
    ffn_w_up = nrm(ks[18], (N_DENSE, D, D_FF), D ** -0.5)
    ffn_w_down = nrm(ks[19], (N_DENSE, D_FF, D), DEEPNORM_BETA * D_FF ** -0.5)
    router_w = nrm(ks[20], (N_MOE, D, N_EXPERTS), D ** -0.5)
    router_b = nrm(ks[21], (N_MOE, N_EXPERTS), 0.01)
    expert_w_gate = nrm(ks[22], (N_MOE, N_EXPERTS, D, D_FF_EXPERT), D ** -0.5)
    expert_w_up = nrm(ks[23], (N_MOE, N_EXPERTS, D, D_FF_EXPERT), D ** -0.5)
    expert_w_down = nrm(ks[24], (N_MOE, N_EXPERTS, D_FF_EXPERT, D), DEEPNORM_BETA * D_FF_EXPERT ** -0.5)
    return {'x': x, 'c': c, 'positions': positions, 'rel_bias': rel_bias,
            'w_ada': w_ada, 'b_ada': b_ada, 'w_in': w_in, 'w_out': w_out,
            'conv_w': conv_w, 'conv_b': conv_b, 'dt_bias': dt_bias, 'a_log': a_log,
            'd_skip': d_skip, 'ssd_norm_w': ssd_norm_w, 'sinks': sinks,
            'ln_g': ln_g, 'ln_b': ln_b,
            'ffn_w_gate': ffn_w_gate, 'ffn_w_up': ffn_w_up, 'ffn_w_down': ffn_w_down,
            'router_w': router_w, 'router_b': router_b,
            'expert_w_gate': expert_w_gate, 'expert_w_up': expert_w_up, 'expert_w_down': expert_w_down}


def reference(x, c, positions, rel_bias, w_ada, b_ada, w_in, w_out, conv_w, conv_b,
              dt_bias, a_log, d_skip, ssd_norm_w, sinks, ln_g, ln_b,
              ffn_w_gate, ffn_w_up, ffn_w_down, router_w, router_b,
              expert_w_gate, expert_w_up, expert_w_down):
    split_idx = np.cumsum(IN_SIZES)[:-1].tolist()
    for layer in range(DEPTH):
        mod = c @ w_ada[layer] + b_ada[layer]
        sh_a, sc_a, g_a, sh_f, sc_f, g_f = [m[:, None, :] for m in jnp.split(mod, 6, -1)]
        h = x * (1.0 + sc_a) + sh_a
        u = h @ w_in[layer]
        rq, rk, rv, rg, sz, sxbc, sdt, aq, ak, av = jnp.split(u, split_idx, -1)
        y_ret = _retention(rq, rk, rv, rg, positions)
        y_ssd = _ssd(sz, sxbc, sdt, conv_w[layer], conv_b[layer], dt_bias[layer],
                     a_log[layer], d_skip[layer], ssd_norm_w[layer])
        y_swa = _swa(aq, ak, av, rel_bias, sinks[layer])
        mix = jnp.concatenate([y_ret, y_ssd, y_swa], -1) @ w_out[layer]
        x = _layer_norm(DEEPNORM_ALPHA * x + (1.0 + g_a) * mix, ln_g[layer, 0], ln_b[layer, 0])
        h = x * (1.0 + sc_f) + sh_f
        if layer % 2 == 0:
            i = layer // 2
            f = _swiglu(h, ffn_w_gate[i], ffn_w_up[i], ffn_w_down[i])
        else:
            i = layer // 2
            f = _moe(h, router_w[i], router_b[i], expert_w_gate[i], expert_w_up[i], expert_w_down[i])
        x = _layer_norm(DEEPNORM_ALPHA * x + (1.0 + g_f) * f, ln_g[layer, 1], ln_b[layer, 1])
    return x
```

```cpp
#ifndef CPU_EMU
#include <hip/hip_runtime.h>
#endif
#include <stdint.h>
#include <stdio.h>
#include <math.h>
#include <string.h>
#include <stddef.h>

#ifndef SEQ_
#define SEQ_ 8192
#endif
#ifndef DFF_
#define DFF_ 2816
#endif
#ifndef DFFE_
#define DFFE_ 3584
#endif
constexpr int D = 1024, NB = 2, L = SEQ_, T = NB * L, CH = 128, NCH = L / CH;
constexpr int DFF = DFF_, DFFE = DFFE_, NE = 8;
constexpr int IN_DIM = 2824, UN = 2816;
constexpr int U_RQ = 0, U_RK = 256, U_RV = 512, U_RG = 768, U_SZ = 1024, U_XS = 1536, U_AQ = 2304, U_AK = 2560, U_AV = 2688;
constexpr int W_DT = 2304;
constexpr int XBC = 768;
constexpr float LN_EPS = 1e-5f;
constexpr float ALPHA = 1.41421356237309515f;
constexpr int CAPT = 72, CAPR = CAPT * 256;
constexpr int MAXROWS = (2 * T / 256 + NE) * 256;

#ifdef CPU_EMU
#define DEV static inline
typedef float act_t;
DEV float a2f(act_t v) { return v; }
DEV act_t f2a(float f) { return f; }
DEV int atomic_inc(int* p) { return __sync_fetch_and_add(p, 1); }
#else
#define DEV __device__ __forceinline__
typedef unsigned short act_t;
DEV float a2f(act_t v) { return __uint_as_float(((unsigned)v) << 16); }
DEV act_t f2a(float f) { unsigned u = __float_as_uint(f); return (act_t)((u + 0x7fffu + ((u >> 16) & 1u)) >> 16); }
DEV int atomic_inc(int* p) { return atomicAdd(p, 1); }
#endif

DEV float siluf(float x) { return x / (1.0f + expf(-x)); }
DEV float softplusf(float x) { return x > 20.f ? x : log1pf(expf(x)); }
DEV float loggamma(int h) { return logf(1.0f - exp2f(-5.0f - (float)h)); }

#ifdef CPU_EMU
static const unsigned char
#else
__constant__ unsigned char
#endif
T5B[128] = {0, 1, 2, 3, 4, 5, 6, 7, 8, 9, 10, 11, 12, 13, 14, 15, 16, 16, 16, 17, 17, 18, 18, 18, 19, 19, 19, 20, 20, 20, 20, 21, 21, 21, 21, 22, 22, 22, 22, 22, 23, 23, 23, 23, 23, 23, 24, 24, 24, 24, 24, 24, 25, 25, 25, 25, 25, 25, 25, 26, 26, 26, 26, 26, 26, 26, 26, 27, 27, 27, 27, 27, 27, 27, 27, 27, 27, 28, 28, 28, 28, 28, 28, 28, 28, 28, 28, 29, 29, 29, 29, 29, 29, 29, 29, 29, 29, 29, 29, 30, 30, 30, 30, 30, 30, 30, 30, 30, 30, 30, 30, 30, 30, 31, 31, 31, 31, 31, 31, 31, 31, 31, 31, 31, 31, 31, 31, 31};

struct P {
    const float* x; const float* c; const int* pos; const float* rel_bias; const float* w_ada; const float* b_ada; const float* w_in; const float* w_out;
    const float* conv_w; const float* conv_b; const float* dt_bias; const float* a_log; const float* d_skip; const float* ssd_norm_w; const float* sinks;
    const float* ln_g; const float* ln_b; const float* ffn_wg; const float* ffn_wu; const float* ffn_wd; const float* router_w; const float* router_b;
    const float* ex_wg; const float* ex_wu; const float* ex_wd;
    float* out;
    float* mod;
    float* cs;
    act_t* hb;
    act_t* u;
    float* dtraw;
    float* dt;
    float* acs;
    act_t* xbc;
    float* st_ret;
    float* st_ssd;
    float* cdec;
    float* oraw;
    float* yraw;
    act_t* ymix;
    float* gout;
    float* xb;
    act_t* act;
    act_t* ybuf;
    int* cnt;
    int* slot_tok;
    int* top_e;
    int* top_p;
    float* top_w;
};

#define ITEMS(n) for (long it = gtid; it < (long)(n); it += gsz)

DEV void ph_mod(const P& p, long gtid, long gsz) {
    ITEMS(2 * NB * 6 * D) {
        const int n = (int)(it % (6 * D)), b = (int)((it / (6 * D)) % NB), l = (int)(it / (6 * D * NB));
        const float* w = p.w_ada + (size_t)l * D * 6 * D + n; const float* cv = p.c + (size_t)b * D;
        float acc = 0.f;
        for (int k = 0; k < D; ++k) acc += cv[k] * w[(size_t)k * 6 * D];
        p.mod[it] = acc + p.b_ada[l * 6 * D + n];
    }
}
DEV void ph_rotab(const P& p, long gtid, long gsz) {
    ITEMS(T * 32) {
        const int i = (int)(it % 32); const long t = it / 32;
        const float inv = expf((-9.210340371976184f * (float)i) / 32.0f);
        const float ang = (float)p.pos[t] * inv;
        p.cs[t * 64 + i] = (float)cos((double)ang); p.cs[t * 64 + 32 + i] = (float)sin((double)ang);
    }
}
DEV void ph_modulate(const P& p, int layer, const float* xin, int sel, long gtid, long gsz) {
    ITEMS((long)T * D) {
        const int d = (int)(it % D); const long t = it / D; const int b = (int)(t / L);
        const float* m = p.mod + ((size_t)layer * NB + b) * 6 * D + sel * 3 * D;
        p.hb[it] = f2a(xin[it] * (1.0f + m[D + d]) + m[d]);
    }
}
DEV void ph_dtraw(const P& p, int layer, const float* xin, long gtid, long gsz) {
    ITEMS((long)T * 8) {
        const int j = (int)(it % 8); const long t = it / 8; const int b = (int)(t / L);
        const float* m = p.mod + ((size_t)layer * NB + b) * 6 * D; const float* w = p.w_in + (size_t)layer * D * IN_DIM + W_DT + j;
        float acc = 0.f;
        for (int d = 0; d < D; ++d) acc += (xin[t * D + d] * (1.0f + m[D + d]) + m[d]) * w[(size_t)d * IN_DIM];
        p.dtraw[it] = acc;
    }
}
DEV void ph_rotary(const P& p, long gtid, long gsz) {
    ITEMS((long)T * 256) {
        const int i = (int)(it % 32), h = (int)((it / 32) % 4), which = (int)((it / 128) % 2); const long t = it / 256;
        act_t* q = p.u + (size_t)t * UN + (which ? U_RK : U_RQ) + h * 64;
        const float c = p.cs[t * 64 + i], s = p.cs[t * 64 + 32 + i];
        const float t1 = a2f(q[i]), t2 = a2f(q[32 + i]); const float sc = which ? 0.125f : 1.0f;
        q[i] = f2a((t1 * c - t2 * s) * sc); q[32 + i] = f2a((t1 * s + t2 * c) * sc);
    }
}
DEV void ph_conv(const P& p, int layer, long gtid, long gsz) {
    ITEMS((long)T * XBC) {
        const int c = (int)(it % XBC); const long t = it / XBC; const int l = (int)(t % L);
        float acc = p.conv_b[layer * XBC + c];
        for (int w = 0; w < 4; ++w) { const int ll = l - 3 + w; if (ll >= 0) acc += a2f(p.u[(size_t)(t - 3 + w) * UN + U_XS + c]) * p.conv_w[((size_t)layer * 4 + w) * XBC + c]; }
        p.xbc[it] = f2a(siluf(acc));
    }
}
DEV void ph_dt(const P& p, int layer, long gtid, long gsz) {
    ITEMS(NB * NCH * 8) {
        const int hd = (int)(it % 8); const long bc = it / 8;
        const float bias = p.dt_bias[layer * 8 + hd], A = -expf(p.a_log[layer * 8 + hd]);
        float cs = 0.f;
        for (int i = 0; i < CH; ++i) { const long t = bc * CH + i; const float dt = softplusf(p.dtraw[t * 8 + hd] + bias); cs += A * dt; p.dt[t * 8 + hd] = dt; p.acs[t * 8 + hd] = cs; }
        p.cdec[it] = expf(cs);
    }
}
DEV void ph_ret_state(const P& p, long gtid, long gsz) {
    ITEMS((long)NB * NCH * 4 * 4096) {
        const int e = (int)(it % 64), d = (int)((it / 64) % 64), h = (int)((it / 4096) % 4); const long bc = it / (4096 * 4);
        const float lg = loggamma(h); float acc = 0.f;
        for (int j = 0; j < CH; ++j) { const act_t* r = p.u + (size_t)(bc * CH + j) * UN; acc += a2f(r[U_RK + h * 64 + d]) * expf(lg * (float)(CH - 1 - j)) * a2f(r[U_RV + h * 64 + e]); }
        p.st_ret[it] = acc;
    }
}
DEV void ph_ssd_state(const P& p, long gtid, long gsz) {
    ITEMS((long)NB * NCH * 8 * 4096) {
        const int n = (int)(it % 64), pp = (int)((it / 64) % 64), hd = (int)((it / 4096) % 8); const long bc = it / (4096 * 8); const int g = hd / 4;
        const float alast = p.acs[(bc * CH + CH - 1) * 8 + hd]; float acc = 0.f;
        for (int l = 0; l < CH; ++l) { const long t = bc * CH + l; const act_t* r = p.xbc + (size_t)t * XBC;
            acc += a2f(r[512 + g * 64 + n]) * expf(alast - p.acs[t * 8 + hd]) * (a2f(r[hd * 64 + pp]) * p.dt[t * 8 + hd]); }
        p.st_ssd[it] = acc;
    }
}
DEV void ph_scan(const P& p, long gtid, long gsz) {
    ITEMS((long)NB * 4 * 4096 + (long)NB * 8 * 4096) {
        if (it < (long)NB * 4 * 4096) {
            const int el = (int)(it % 4096), h = (int)((it / 4096) % 4), b = (int)(it / (4096 * 4));
            const float dec = expf(loggamma(h) * (float)CH); float S = 0.f;
            for (int c = 0; c < NCH; ++c) { float* q = p.st_ret + (((size_t)b * NCH + c) * 4 + h) * 4096 + el; const float v = *q; *q = S; S = dec * S + v; }
        } else {
            const long i2 = it - (long)NB * 4 * 4096; const int el = (int)(i2 % 4096), hd = (int)((i2 / 4096) % 8), b = (int)(i2 / (4096 * 8));
            float S = 0.f;
            for (int c = 0; c < NCH; ++c) { float* q = p.st_ssd + (((size_t)b * NCH + c) * 8 + hd) * 4096 + el; const float v = *q; *q = S; S = p.cdec[((size_t)b * NCH + c) * 8 + hd] * S + v; }
        }
    }
}
DEV void ph_ret_o(const P& p, long gtid, long gsz) {
    ITEMS((long)T * 256) {
        const int e = (int)(it % 64), h = (int)((it / 64) % 4); const long t = it / 256; const int i = (int)(t % CH); const long bc = t / CH;
        const float lg = loggamma(h); const act_t* qi = p.u + (size_t)t * UN + U_RQ + h * 64;
        float acc = 0.f;
        for (int j = 0; j <= i; ++j) { const act_t* r = p.u + (size_t)(bc * CH + j) * UN; float s = 0.f;
            for (int d = 0; d < 64; ++d) s += a2f(qi[d]) * a2f(r[U_RK + h * 64 + d]);
            acc += s * expf(lg * (float)(i - j)) * a2f(r[U_RV + h * 64 + e]); }
        const float* pv = p.st_ret + ((size_t)bc * 4 + h) * 4096; float cr = 0.f;
        for (int d = 0; d < 64; ++d) cr += a2f(qi[d]) * pv[d * 64 + e];
        p.oraw[it] = acc + expf(lg * (float)(i + 1)) * cr;
    }
}
DEV void ph_ret_norm(const P& p, long gtid, long gsz) {
    ITEMS((long)T * 4) {
        const int h = (int)(it % 4); const long t = it / 4; const float* o = p.oraw + t * 256 + h * 64;
        float mu = 0.f; for (int e = 0; e < 64; ++e) mu += o[e]; mu *= (1.0f / 64.0f);
        float var = 0.f; for (int e = 0; e < 64; ++e) { const float dlt = o[e] - mu; var += dlt * dlt; } var *= (1.0f / 64.0f);
        const float rs = 1.0f / sqrtf(var + LN_EPS);
        for (int e = 0; e < 64; ++e) { const float g = a2f(p.u[(size_t)t * UN + U_RG + h * 64 + e]); p.ymix[(size_t)t * D + h * 64 + e] = f2a(siluf(g) * ((o[e] - mu) * rs)); }
    }
}
DEV void ph_ssd_y(const P& p, int layer, long gtid, long gsz) {
    ITEMS((long)T * 512) {
        const int pp = (int)(it % 64), hd = (int)((it / 64) % 8); const long t = it / 512; const int l = (int)(t % CH); const long bc = t / CH; const int g = hd / 4;
        const act_t* rl = p.xbc + (size_t)t * XBC; const float al = p.acs[t * 8 + hd];
        float acc = 0.f;
        for (int s = 0; s <= l; ++s) { const long ts = bc * CH + s; const act_t* rs = p.xbc + (size_t)ts * XBC; float cb = 0.f;
            for (int n = 0; n < 64; ++n) cb += a2f(rl[640 + g * 64 + n]) * a2f(rs[512 + g * 64 + n]);
            acc += cb * expf(al - p.acs[ts * 8 + hd]) * (a2f(rs[hd * 64 + pp]) * p.dt[ts * 8 + hd]); }
        const float* pv = p.st_ssd + ((size_t)bc * 8 + hd) * 4096 + pp * 64; float off = 0.f;
        for (int n = 0; n < 64; ++n) off += a2f(rl[640 + g * 64 + n]) * pv[n];
        p.yraw[it] = acc + off * expf(al) + a2f(rl[hd * 64 + pp]) * p.d_skip[layer * 8 + hd];
    }
}
DEV void ph_ssd_norm(const P& p, int layer, long gtid, long gsz) {
    ITEMS((long)T * 2) {
        const int g = (int)(it % 2); const long t = it / 2;
        float ms = 0.f;
        for (int k = 0; k < 256; ++k) { const int ch = g * 256 + k; const float hv = p.yraw[t * 512 + ch] * siluf(a2f(p.u[(size_t)t * UN + U_SZ + ch])); ms += hv * hv; }
        const float rs = 1.0f / sqrtf(ms * (1.0f / 256.0f) + LN_EPS);
        for (int k = 0; k < 256; ++k) { const int ch = g * 256 + k; const float hv = p.yraw[t * 512 + ch] * siluf(a2f(p.u[(size_t)t * UN + U_SZ + ch]));
            p.ymix[(size_t)t * D + 256 + ch] = f2a(hv * rs * p.ssd_norm_w[layer * 512 + ch]); }
    }
}
DEV void ph_swa(const P& p, int layer, long gtid, long gsz) {
    ITEMS((long)T * 256) {
        const int d = (int)(it % 64), hq = (int)((it / 64) % 4); const long t = it / 256; const int l = (int)(t % L); const int kvh = hq / 2;
        const act_t* q = p.u + (size_t)t * UN + U_AQ + hq * 64;
        float m = p.sinks[layer * 4 + hq], den = 1.0f, acc = 0.f;
        const int j0 = l - 127 > 0 ? l - 127 : 0;
        for (int j = j0; j <= l; ++j) { const act_t* r = p.u + (size_t)(t - l + j) * UN; float s = 0.f;
            for (int dd = 0; dd < 64; ++dd) s += a2f(q[dd]) * a2f(r[U_AK + kvh * 64 + dd]);
            s = s * 0.125f + p.rel_bias[T5B[l - j] * 4 + hq];
            if (s > m) { const float sc = expf(m - s); den *= sc; acc *= sc; m = s; }
            const float pr = expf(s - m); den += pr; acc += pr * a2f(r[U_AV + kvh * 64 + d]); }
        p.ymix[(size_t)t * D + 768 + hq * 64 + d] = f2a(acc / den);
    }
}
DEV int moe_rb(const P& p, int e) { int acc = 0; for (int k = 0; k < NE; ++k) if (k < e) acc += (p.cnt[k] + 255) / 256 * 256; return acc; }
DEV float ln_fval(const P& p, int fsrc, long t, int d, size_t r0, size_t r1) {
    if (fsrc == 0) return p.gout[t * D + d];
    return p.top_w[t * 2] * a2f(p.ybuf[r0 * D + d]) + p.top_w[t * 2 + 1] * a2f(p.ybuf[r1 * D + d]);
}
DEV void ph_ln(const P& p, int layer, int which, const float* xin, float* xout, int fsrc, int hl, int hsel, long gtid, long gsz) {
    ITEMS(T) {
        const long t = it; const int b = (int)(t / L);
        size_t r0 = 0, r1 = 0; if (fsrc == 1) { r0 = (size_t)moe_rb(p, p.top_e[t * 2]) + p.top_p[t * 2]; r1 = (size_t)moe_rb(p, p.top_e[t * 2 + 1]) + p.top_p[t * 2 + 1]; }
        const float* gate = p.mod + ((size_t)layer * NB + b) * 6 * D + (which ? 5 : 2) * D;
        float mu = 0.f; for (int d = 0; d < D; ++d) mu += ALPHA * xin[t * D + d] + (1.0f + gate[d]) * ln_fval(p, fsrc, t, d, r0, r1); mu *= (1.0f / D);
        float var = 0.f; for (int d = 0; d < D; ++d) { const float v = ALPHA * xin[t * D + d] + (1.0f + gate[d]) * ln_fval(p, fsrc, t, d, r0, r1) - mu; var += v * v; } var *= (1.0f / D);
        const float rs = 1.0f / sqrtf(var + LN_EPS);
        const float* lg = p.ln_g + ((size_t)layer * 2 + which) * D; const float* lb = p.ln_b + ((size_t)layer * 2 + which) * D;
        const float* m = hl >= 0 ? p.mod + ((size_t)hl * NB + b) * 6 * D + hsel * 3 * D : nullptr;
        for (int d = 0; d < D; ++d) { const float v = ALPHA * xin[t * D + d] + (1.0f + gate[d]) * ln_fval(p, fsrc, t, d, r0, r1);
            const float o = (v - mu) * rs * lg[d] + lb[d]; xout[t * D + d] = o;
            if (m) p.hb[t * D + d] = f2a(o * (1.0f + m[D + d]) + m[d]); }
    }
}
DEV void ph_route(const P& p, int layer, const float* xin, long gtid, long gsz) {
    ITEMS(T) {
        const long t = it; const int b = (int)(t / L);
        const float* m = p.mod + ((size_t)layer * NB + b) * 6 * D + 3 * D;
        float lg0 = 0, lg1 = 0, lg2 = 0, lg3 = 0, lg4 = 0, lg5 = 0, lg6 = 0, lg7 = 0;
        for (int d = 0; d < D; ++d) { const float hv = xin[t * D + d] * (1.0f + m[D + d]) + m[d]; const float* w = p.router_w + (size_t)d * NE;
            lg0 += hv * w[0]; lg1 += hv * w[1]; lg2 += hv * w[2]; lg3 += hv * w[3]; lg4 += hv * w[4]; lg5 += hv * w[5]; lg6 += hv * w[6]; lg7 += hv * w[7]; }
        float v1 = -3.0e38f, v2 = -3.0e38f; int i1 = 0, i2 = 0;
#define RT_STEP(e, val) { const float vv = (val) + p.router_b[e]; if (vv > v1) { v2 = v1; i2 = i1; v1 = vv; i1 = e; } else if (vv > v2) { v2 = vv; i2 = e; } }
        RT_STEP(0, lg0) RT_STEP(1, lg1) RT_STEP(2, lg2) RT_STEP(3, lg3) RT_STEP(4, lg4) RT_STEP(5, lg5) RT_STEP(6, lg6) RT_STEP(7, lg7)
#undef RT_STEP
        const float w1 = 1.0f / (1.0f + expf(v2 - v1));
        const int p1 = atomic_inc(p.cnt + i1), p2 = atomic_inc(p.cnt + i2);
        p.slot_tok[(size_t)i1 * T + p1] = (int)t; p.slot_tok[(size_t)i2 * T + p2] = (int)t;
        p.top_e[t * 2] = i1; p.top_e[t * 2 + 1] = i2; p.top_p[t * 2] = p1; p.top_p[t * 2 + 1] = p2; p.top_w[t * 2] = w1; p.top_w[t * 2 + 1] = 1.0f - w1;
    }
}

struct GG { const act_t* A; int lda; const int* gather; int M; const float* B; const float* B2; int ldb; int skip_at, skip_by; int K; void* C; int ldc; int mode; };
#ifdef CPU_EMU
static void gg_tile(const GG& g, int mt, int nt) {
    for (int r = 0; r < 128; ++r) { const int m = mt * 128 + r; if (m >= g.M) break; const int ar = g.gather ? g.gather[m] : m;
        for (int cc = 0; cc < 64; ++cc) { const int n = nt * 64 + cc, bc = n >= g.skip_at ? n + g.skip_by : n; float a1 = 0.f, a2 = 0.f;
            for (int k = 0; k < g.K; ++k) { const float av = g.A[(size_t)ar * g.lda + k]; a1 += av * g.B[(size_t)k * g.ldb + bc]; if (g.mode == 2) a2 += av * g.B2[(size_t)k * g.ldb + bc]; }
            if (g.mode == 0) ((float*)g.C)[(size_t)m * g.ldc + n] = a1; else ((act_t*)g.C)[(size_t)m * g.ldc + n] = f2a(g.mode == 2 ? siluf(a1) * a2 : a1); } }
}
#else
__device__ __forceinline__ void gg_tile(const GG& g, int mt, int nt, float* sm) {
    float* As = sm; float* Bs = sm + 16 * 132; float* B2s = Bs + 16 * 64;
    const int tid = threadIdx.x, ty = tid >> 4, tx = tid & 15;
    float a1[4][4], a2[4][4];
#pragma unroll
    for (int i = 0; i < 4; ++i)
#pragma unroll
        for (int j = 0; j < 4; ++j) { a1[i][j] = 0.f; a2[i][j] = 0.f; }
    const int ar_ = tid >> 2, ak_ = (tid & 3) * 4; const int am = mt * 128 + ar_; const bool aval = am < g.M;
    const int arow = aval ? (g.gather ? g.gather[am] : am) : 0;
    const act_t* Ap = g.A + (size_t)arow * g.lda + ak_;
    const int bk_ = tid >> 5, bn_ = (tid & 31) * 2; const int n0 = nt * 64 + bn_;
    const int bc0 = n0 >= g.skip_at ? n0 + g.skip_by : n0, bc1 = (n0 + 1) >= g.skip_at ? n0 + 1 + g.skip_by : n0 + 1;
    for (int k0 = 0; k0 < g.K; k0 += 16) {
#pragma unroll
        for (int i = 0; i < 4; ++i) As[(ak_ + i) * 132 + ar_] = aval ? a2f(Ap[k0 + i]) : 0.f;
        const float* bp = g.B + (size_t)(k0 + bk_) * g.ldb; Bs[bk_ * 64 + bn_] = bp[bc0]; Bs[bk_ * 64 + bn_ + 1] = bp[bc1];
        if (g.mode == 2) { const float* bp2 = g.B2 + (size_t)(k0 + bk_) * g.ldb; B2s[bk_ * 64 + bn_] = bp2[bc0]; B2s[bk_ * 64 + bn_ + 1] = bp2[bc1]; }
        __syncthreads();
#pragma unroll
        for (int k = 0; k < 16; ++k) {
            float av[4], bv[4], cv[4];
#pragma unroll
            for (int i = 0; i < 4; ++i) { av[i] = As[k * 132 + ty * 4 + i]; bv[i] = Bs[k * 64 + tx * 4 + i]; cv[i] = g.mode == 2 ? B2s[k * 64 + tx * 4 + i] : 0.f; }
#pragma unroll
            for (int i = 0; i < 4; ++i)
#pragma unroll
                for (int j = 0; j < 4; ++j) { a1[i][j] += av[i] * bv[j]; if (g.mode == 2) a2[i][j] += av[i] * cv[j]; }
        }
        __syncthreads();
    }
#pragma unroll
    for (int i = 0; i < 4; ++i) { const int m = mt * 128 + ty * 4 + i; if (m < g.M) {
#pragma unroll
        for (int j = 0; j < 4; ++j) { const int n = nt * 64 + tx * 4 + j;
            if (g.mode == 0) ((float*)g.C)[(size_t)m * g.ldc + n] = a1[i][j]; else ((act_t*)g.C)[(size_t)m * g.ldc + n] = f2a(g.mode == 2 ? siluf(a1[i][j]) * a2[i][j] : a1[i][j]); } } }
}
#endif

#ifdef CPU_EMU
#define GG_TILE(g, mt, nt) gg_tile(g, mt, nt)
#define SM_ARG
#define SM_PARM
#else
#define GG_TILE(g, mt, nt) gg_tile(g, mt, nt, sm)
#define SM_ARG , sm
#define SM_PARM , float* sm
#endif
DEV void ph_gemm_plain(const GG& g, int N, int bid, int nblk SM_PARM) {
    const int ntn = N / 64, ntm = (g.M + 127) / 128;
    for (int tIdx = bid; tIdx < ntn * ntm; tIdx += nblk) GG_TILE(g, tIdx / ntn, tIdx % ntn);
}
DEV void ph_gemm_moe(const P& p, int which, int pass, int bid, int nblk SM_PARM) {
    const int N = which ? D : DFFE, ntn = N / 64, ntm = T / 128;
    for (long tIdx = bid; tIdx < (long)NE * ntm * ntn; tIdx += nblk) {
        const int nt = (int)(tIdx % ntn), mt = (int)((tIdx / ntn) % ntm), e = (int)(tIdx / ((long)ntn * ntm));
        if (mt * 128 >= p.cnt[e]) continue;
        const int rbe = moe_rb(p, e); const ptrdiff_t arow0 = (ptrdiff_t)rbe - (ptrdiff_t)pass * CAPR;
        const int grow = rbe + mt * 128;
        if (grow < pass * CAPR || grow >= (pass + 1) * CAPR) continue;
        GG g;
        if (which == 0) { g.A = p.hb; g.lda = D; g.gather = p.slot_tok + (size_t)e * T; g.M = p.cnt[e]; g.B = p.ex_wg + (size_t)e * D * DFFE; g.B2 = p.ex_wu + (size_t)e * D * DFFE; g.ldb = DFFE;
            g.skip_at = 1 << 30; g.skip_by = 0; g.K = D; g.C = p.act + arow0 * DFFE; g.ldc = DFFE; g.mode = 2; }
        else { g.A = p.act + arow0 * DFFE; g.lda = DFFE; g.gather = nullptr; g.M = p.cnt[e]; g.B = p.ex_wd + (size_t)e * DFFE * D; g.B2 = nullptr; g.ldb = D;
            g.skip_at = 1 << 30; g.skip_by = 0; g.K = DFFE; g.C = p.ybuf + (size_t)rbe * D; g.ldc = D; g.mode = 1; }
        GG_TILE(g, mt, nt);
    }
}

constexpr size_t al256(size_t v) { return (v + 255) & ~(size_t)255; }
struct WsMap {
    size_t mod, cs, hb, u, dtraw, dt, acs, xbc, st_ret, st_ssd, cdec, oraw, yraw, ymix, gout, xb, act, ybuf, cnt, slot_tok, top_e, top_p, top_w, end;
};
static WsMap make_map() {
    WsMap m; size_t o = 0;
    const size_t A = sizeof(act_t);
    m.cnt = o; o += 256;
    m.mod = o; o += al256((size_t)2 * NB * 6 * D * 4);
    m.cs = o; o += al256((size_t)T * 64 * 4);
    m.hb = o; o += al256((size_t)T * D * A);
    m.dtraw = o; o += al256((size_t)T * 8 * 4);
    m.dt = o; o += al256((size_t)T * 8 * 4);
    m.acs = o; o += al256((size_t)T * 8 * 4);
    m.cdec = o; o += al256((size_t)NB * NCH * 8 * 4);
    m.gout = o; o += al256((size_t)T * D * 4);
    m.xb = o; o += al256((size_t)T * D * 4);
    m.slot_tok = o; o += al256((size_t)NE * T * 4);
    m.top_e = o; o += al256((size_t)T * 2 * 4);
    m.top_p = o; o += al256((size_t)T * 2 * 4);
    m.top_w = o; o += al256((size_t)T * 2 * 4);
    const size_t r1 = o; size_t r1e = r1;
    m.u = r1; m.ymix = r1 + al256((size_t)T * UN * A); r1e = m.ymix + al256((size_t)T * D * A);
    m.act = r1; { size_t e1 = r1 + al256((size_t)T * DFF * A); if (e1 > r1e) r1e = e1; size_t e2 = r1 + al256((size_t)CAPR * DFFE * A); if (e2 > r1e) r1e = e2; }
    o = r1e;
    const size_t r2 = o; size_t q = r2;
    m.xbc = q; q += al256((size_t)T * XBC * A);
    m.st_ret = q; q += al256((size_t)NB * NCH * 4 * 4096 * 4);
    m.st_ssd = q; q += al256((size_t)NB * NCH * 8 * 4096 * 4);
    m.oraw = q; q += al256((size_t)T * 256 * 4);
    m.yraw = q; q += al256((size_t)T * 512 * 4);
    m.ybuf = r2; { size_t e = r2 + al256((size_t)MAXROWS * D * A); if (e > q) q = e; }
    o = q;
    m.end = o;
    return m;
}

static void fill_params(P& p, void* const* d_in, void* d_out, void* d_ws, const WsMap& m) {
    p.x = (const float*)d_in[0]; p.c = (const float*)d_in[1]; p.pos = (const int*)d_in[2]; p.rel_bias = (const float*)d_in[3]; p.w_ada = (const float*)d_in[4]; p.b_ada = (const float*)d_in[5];
    p.w_in = (const float*)d_in[6]; p.w_out = (const float*)d_in[7]; p.conv_w = (const float*)d_in[8]; p.conv_b = (const float*)d_in[9]; p.dt_bias = (const float*)d_in[10]; p.a_log = (const float*)d_in[11];
    p.d_skip = (const float*)d_in[12]; p.ssd_norm_w = (const float*)d_in[13]; p.sinks = (const float*)d_in[14]; p.ln_g = (const float*)d_in[15]; p.ln_b = (const float*)d_in[16];
    p.ffn_wg = (const float*)d_in[17]; p.ffn_wu = (const float*)d_in[18]; p.ffn_wd = (const float*)d_in[19]; p.router_w = (const float*)d_in[20]; p.router_b = (const float*)d_in[21];
    p.ex_wg = (const float*)d_in[22]; p.ex_wu = (const float*)d_in[23]; p.ex_wd = (const float*)d_in[24];
    p.out = (float*)d_out;
    char* w = (char*)d_ws;
    p.mod = (float*)(w + m.mod); p.cs = (float*)(w + m.cs); p.hb = (act_t*)(w + m.hb); p.u = (act_t*)(w + m.u); p.dtraw = (float*)(w + m.dtraw); p.dt = (float*)(w + m.dt); p.acs = (float*)(w + m.acs);
    p.xbc = (act_t*)(w + m.xbc); p.st_ret = (float*)(w + m.st_ret); p.st_ssd = (float*)(w + m.st_ssd); p.cdec = (float*)(w + m.cdec); p.oraw = (float*)(w + m.oraw); p.yraw = (float*)(w + m.yraw);
    p.ymix = (act_t*)(w + m.ymix); p.gout = (float*)(w + m.gout); p.xb = (float*)(w + m.xb); p.act = (act_t*)(w + m.act); p.ybuf = (act_t*)(w + m.ybuf);
    p.cnt = (int*)(w + m.cnt); p.slot_tok = (int*)(w + m.slot_tok); p.top_e = (int*)(w + m.top_e); p.top_p = (int*)(w + m.top_p); p.top_w = (float*)(w + m.top_w);
}

enum { PH_MOD = 0, PH_ROTAB, PH_MODUL0, PH_DTRAW, PH_INPROJ, PH_ROTARY, PH_CONV, PH_DT, PH_RSTATE, PH_SSTATE, PH_SCAN, PH_RETO, PH_RETN, PH_SSDY, PH_SSDN, PH_SWA, PH_OUTPROJ, PH_LN1,
       PH_FFN_GU, PH_FFN_DN, PH_LN2, PH_ROUTE, PH_MOE_GU0, PH_MOE_DN0, PH_MOE_GU1, PH_MOE_DN1, PH_LN2M };

template <int ph> DEV void run_phase(const P& p, int layer, long gtid, long gsz, int bid, int nblk SM_PARM) {
    const float* xin = layer == 0 ? p.x : p.xb;
    float* x1 = p.out;
    if constexpr (ph == PH_MOD) ph_mod(p, gtid, gsz);
    if constexpr (ph == PH_ROTAB) ph_rotab(p, gtid, gsz);
    if constexpr (ph == PH_MODUL0) ph_modulate(p, 0, p.x, 0, gtid, gsz);
    if constexpr (ph == PH_DTRAW) ph_dtraw(p, layer, xin, gtid, gsz);
    if constexpr (ph == PH_INPROJ) { GG g; g.A = p.hb; g.lda = D; g.gather = nullptr; g.M = T; g.B = p.w_in + (size_t)layer * D * IN_DIM; g.B2 = nullptr; g.ldb = IN_DIM; g.skip_at = W_DT; g.skip_by = 8; g.K = D; g.C = p.u; g.ldc = UN; g.mode = 1;
        ph_gemm_plain(g, UN, bid, nblk SM_ARG); }
    if constexpr (ph == PH_ROTARY) ph_rotary(p, gtid, gsz);
    if constexpr (ph == PH_CONV) ph_conv(p, layer, gtid, gsz);
    if constexpr (ph == PH_DT) ph_dt(p, layer, gtid, gsz);
    if constexpr (ph == PH_RSTATE) ph_ret_state(p, gtid, gsz);
    if constexpr (ph == PH_SSTATE) ph_ssd_state(p, gtid, gsz);
    if constexpr (ph == PH_SCAN) ph_scan(p, gtid, gsz);
    if constexpr (ph == PH_RETO) ph_ret_o(p, gtid, gsz);
    if constexpr (ph == PH_RETN) ph_ret_norm(p, gtid, gsz);
    if constexpr (ph == PH_SSDY) ph_ssd_y(p, layer, gtid, gsz);
    if constexpr (ph == PH_SSDN) ph_ssd_norm(p, layer, gtid, gsz);
    if constexpr (ph == PH_SWA) ph_swa(p, layer, gtid, gsz);
    if constexpr (ph == PH_OUTPROJ) { GG g; g.A = p.ymix; g.lda = D; g.gather = nullptr; g.M = T; g.B = p.w_out + (size_t)layer * D * D; g.B2 = nullptr; g.ldb = D; g.skip_at = 1 << 30; g.skip_by = 0; g.K = D; g.C = p.gout; g.ldc = D; g.mode = 0;
        ph_gemm_plain(g, D, bid, nblk SM_ARG); }
    if constexpr (ph == PH_LN1) ph_ln(p, layer, 0, xin, x1, 0, layer, 1, gtid, gsz);
    if constexpr (ph == PH_FFN_GU) { GG g; g.A = p.hb; g.lda = D; g.gather = nullptr; g.M = T; g.B = p.ffn_wg; g.B2 = p.ffn_wu; g.ldb = DFF; g.skip_at = 1 << 30; g.skip_by = 0; g.K = D; g.C = p.act; g.ldc = DFF; g.mode = 2;
        ph_gemm_plain(g, DFF, bid, nblk SM_ARG); }
    if constexpr (ph == PH_FFN_DN) { GG g; g.A = p.act; g.lda = DFF; g.gather = nullptr; g.M = T; g.B = p.ffn_wd; g.B2 = nullptr; g.ldb = D; g.skip_at = 1 << 30; g.skip_by = 0; g.K = DFF; g.C = p.gout; g.ldc = D; g.mode = 0;
        ph_gemm_plain(g, D, bid, nblk SM_ARG); }
    if constexpr (ph == PH_LN2) ph_ln(p, layer, 1, x1, p.xb, 0, 1, 0, gtid, gsz);
    if constexpr (ph == PH_ROUTE) ph_route(p, layer, x1, gtid, gsz);
    if constexpr (ph == PH_MOE_GU0) ph_gemm_moe(p, 0, 0, bid, nblk SM_ARG);
    if constexpr (ph == PH_MOE_DN0) ph_gemm_moe(p, 1, 0, bid, nblk SM_ARG);
    if constexpr (ph == PH_MOE_GU1) ph_gemm_moe(p, 0, 1, bid, nblk SM_ARG);
    if constexpr (ph == PH_MOE_DN1) ph_gemm_moe(p, 1, 1, bid, nblk SM_ARG);
    if constexpr (ph == PH_LN2M) ph_ln(p, layer, 1, x1, p.out, 1, -1, 0, gtid, gsz);
}

static const int PROGRAM[][2] = {
    {PH_MOD, 0}, {PH_ROTAB, 0}, {PH_MODUL0, 0},
    {PH_DTRAW, 0}, {PH_INPROJ, 0}, {PH_ROTARY, 0}, {PH_CONV, 0}, {PH_DT, 0}, {PH_RSTATE, 0}, {PH_SSTATE, 0}, {PH_SCAN, 0}, {PH_RETO, 0}, {PH_RETN, 0}, {PH_SSDY, 0}, {PH_SSDN, 0}, {PH_SWA, 0},
    {PH_OUTPROJ, 0}, {PH_LN1, 0}, {PH_FFN_GU, 0}, {PH_FFN_DN, 0}, {PH_LN2, 0},
    {PH_DTRAW, 1}, {PH_INPROJ, 1}, {PH_ROTARY, 1}, {PH_CONV, 1}, {PH_DT, 1}, {PH_RSTATE, 1}, {PH_SSTATE, 1}, {PH_SCAN, 1}, {PH_RETO, 1}, {PH_RETN, 1}, {PH_SSDY, 1}, {PH_SSDN, 1}, {PH_SWA, 1},
    {PH_OUTPROJ, 1}, {PH_LN1, 1}, {PH_ROUTE, 1}, {PH_MOE_GU0, 1}, {PH_MOE_DN0, 1}, {PH_MOE_GU1, 1}, {PH_MOE_DN1, 1}, {PH_LN2M, 1},
};
constexpr int NPROG = sizeof(PROGRAM) / sizeof(PROGRAM[0]);

#ifndef CPU_EMU
template <int ph> __global__ void __launch_bounds__(512, 2) k_phase(P p, int layer) {
    __shared__ float sm[16 * 132 + 2 * 16 * 64];
    run_phase<ph>(p, layer, (long)blockIdx.x * blockDim.x + threadIdx.x, (long)gridDim.x * blockDim.x, blockIdx.x, gridDim.x, sm);
}
typedef void (*kfn_t)(P, int);
template <int... I> struct KTab { static kfn_t get(int ph) { static const kfn_t tab[] = { k_phase<I>... }; return tab[ph]; } };
typedef KTab<0, 1, 2, 3, 4, 5, 6, 7, 8, 9, 10, 11, 12, 13, 14, 15, 16, 17, 18, 19, 20, 21, 22, 23, 24, 25, 26> KT;

extern "C" void kernel_launch(void* const* d_in, const int* in_sizes, int n_in, void* d_out, int out_size, void* d_ws, size_t ws_size, hipStream_t stream) {
    static WsMap m = make_map();
    if (n_in != 25 || out_size != T * D || ws_size < m.end) { fprintf(stderr, "kernel_launch: unexpected sizes (n_in %d out %d ws %zu need %zu)\n", n_in, out_size, ws_size, m.end); return; }
    P p; memset(&p, 0, sizeof(p)); fill_params(p, d_in, d_out, d_ws, m);
    hipMemsetAsync((char*)d_ws + m.cnt, 0, 256, stream);
    for (int i = 0; i < NPROG; ++i) hipLaunchKernelGGL(KT::get(PROGRAM[i][0]), dim3(1024), dim3(512), 0, stream, p, PROGRAM[i][1]);
}
#endif
```

```cpp
#ifndef CPU_EMU
#include <hip/hip_runtime.h>
#endif
#include <stdint.h>
#include <stdio.h>
#include <math.h>
#include <string.h>
#include <stddef.h>

#ifndef SEQ_
#define SEQ_ 8192
#endif
#ifndef DFF_
#define DFF_ 2816
#endif
#ifndef DFFE_
#define DFFE_ 3584
#endif
#ifndef MK_SINGLE
#define MK_SINGLE 1
#endif
constexpr int D = 1024, NB = 2, L = SEQ_, T = NB * L, CH = 128, NCH = L / CH;
constexpr int DFF = DFF_, DFFE = DFFE_, NE = 8;
constexpr int IN_DIM = 2824, UN = 2816;
constexpr int U_RQ = 0, U_RK = 256, U_RV = 512, U_RG = 768, U_SZ = 1024, U_XS = 1536, U_AQ = 2304, U_AK = 2560, U_AV = 2688;
constexpr int W_DT = 2304;
constexpr int XBC = 768;
constexpr float LN_EPS = 1e-5f;
constexpr float ALPHA = 1.41421356237309515f;
constexpr int CAPT = 72, CAPR = CAPT * 256;
constexpr size_t CTL_BYTES = 65536, CTL_BAR_OFF = 4096;
constexpr int MAXROWS = (2 * T / 256 + NE) * 256;

#ifdef CPU_EMU
#define DEV static inline
typedef float act_t;
DEV float a2f(act_t v) { return v; }
DEV act_t f2a(float f) { return f; }
DEV int atomic_inc(int* p) { return __sync_fetch_and_add(p, 1); }
#else
#define DEV __device__ __forceinline__
typedef unsigned short act_t;
DEV float a2f(act_t v) { return __uint_as_float(((unsigned)v) << 16); }
DEV act_t f2a(float f) { unsigned u = __float_as_uint(f); return (act_t)((u + 0x7fffu + ((u >> 16) & 1u)) >> 16); }
DEV int atomic_inc(int* p) { return atomicAdd(p, 1); }
#endif

DEV float siluf(float x) { return x / (1.0f + expf(-x)); }
DEV float softplusf(float x) { return x > 20.f ? x : log1pf(expf(x)); }
DEV float loggamma(int h) { return logf(1.0f - exp2f(-5.0f - (float)h)); }

#ifdef CPU_EMU
static const unsigned char
#else
__constant__ unsigned char
#endif
T5B[128] = {0, 1, 2, 3, 4, 5, 6, 7, 8, 9, 10, 11, 12, 13, 14, 15, 16, 16, 16, 17, 17, 18, 18, 18, 19, 19, 19, 20, 20, 20, 20, 21, 21, 21, 21, 22, 22, 22, 22, 22, 23, 23, 23, 23, 23, 23, 24, 24, 24, 24, 24, 24, 25, 25, 25, 25, 25, 25, 25, 26, 26, 26, 26, 26, 26, 26, 26, 27, 27, 27, 27, 27, 27, 27, 27, 27, 27, 28, 28, 28, 28, 28, 28, 28, 28, 28, 28, 29, 29, 29, 29, 29, 29, 29, 29, 29, 29, 29, 29, 30, 30, 30, 30, 30, 30, 30, 30, 30, 30, 30, 30, 30, 30, 31, 31, 31, 31, 31, 31, 31, 31, 31, 31, 31, 31, 31, 31, 31};

struct P {
    const float* x; const float* c; const int* pos; const float* rel_bias; const float* w_ada; const float* b_ada; const float* w_in; const float* w_out;
    const float* conv_w; const float* conv_b; const float* dt_bias; const float* a_log; const float* d_skip; const float* ssd_norm_w; const float* sinks;
    const float* ln_g; const float* ln_b; const float* ffn_wg; const float* ffn_wu; const float* ffn_wd; const float* router_w; const float* router_b;
    const float* ex_wg; const float* ex_wu; const float* ex_wd;
    float* out;
    float* mod;
    float* cs;
    act_t* hb;
    act_t* u;
    float* dtraw;
    float* dt;
    float* acs;
    act_t* xbc;
    float* st_ret;
    float* st_ssd;
    float* cdec;
    float* oraw;
    float* yraw;
    act_t* ymix;
    float* gout;
    float* xb;
    act_t* act;
    act_t* ybuf;
    int* cnt;
    int* slot_tok;
    unsigned* bar;
    int* top_e;
    int* top_p;
    float* top_w;
};

#define ITEMS(n) for (long it = gtid; it < (long)(n); it += gsz)

DEV void ph_mod(const P& p, long gtid, long gsz) {
    ITEMS(2 * NB * 6 * D) {
        const int n = (int)(it % (6 * D)), b = (int)((it / (6 * D)) % NB), l = (int)(it / (6 * D * NB));
        const float* w = p.w_ada + (size_t)l * D * 6 * D + n; const float* cv = p.c + (size_t)b * D;
        float acc = 0.f;
        for (int k = 0; k < D; ++k) acc += cv[k] * w[(size_t)k * 6 * D];
        p.mod[it] = acc + p.b_ada[l * 6 * D + n];
    }
}
DEV void ph_rotab(const P& p, long gtid, long gsz) {
    ITEMS(T * 32) {
        const int i = (int)(it % 32); const long t = it / 32;
        const float inv = expf((-9.210340371976184f * (float)i) / 32.0f);
        const float ang = (float)p.pos[t] * inv;
        p.cs[t * 64 + i] = (float)cos((double)ang); p.cs[t * 64 + 32 + i] = (float)sin((double)ang);
    }
}
DEV void ph_modulate(const P& p, int layer, const float* xin, int sel, long gtid, long gsz) {
    ITEMS((long)T * D) {
        const int d = (int)(it % D); const long t = it / D; const int b = (int)(t / L);
        const float* m = p.mod + ((size_t)layer * NB + b) * 6 * D + sel * 3 * D;
        p.hb[it] = f2a(xin[it] * (1.0f + m[D + d]) + m[d]);
    }
}
DEV void ph_dtraw(const P& p, int layer, const float* xin, long gtid, long gsz) {
    ITEMS((long)T * 8) {
        const int j = (int)(it % 8); const long t = it / 8; const int b = (int)(t / L);
        const float* m = p.mod + ((size_t)layer * NB + b) * 6 * D; const float* w = p.w_in + (size_t)layer * D * IN_DIM + W_DT + j;
        float acc = 0.f;
        for (int d = 0; d < D; ++d) acc += (xin[t * D + d] * (1.0f + m[D + d]) + m[d]) * w[(size_t)d * IN_DIM];
        p.dtraw[it] = acc;
    }
}
DEV void ph_rotary(const P& p, long gtid, long gsz) {
    ITEMS((long)T * 256) {
        const int i = (int)(it % 32), h = (int)((it / 32) % 4), which = (int)((it / 128) % 2); const long t = it / 256;
        act_t* q = p.u + (size_t)t * UN + (which ? U_RK : U_RQ) + h * 64;
        const float c = p.cs[t * 64 + i], s = p.cs[t * 64 + 32 + i];
        const float t1 = a2f(q[i]), t2 = a2f(q[32 + i]); const float sc = which ? 0.125f : 1.0f;
        q[i] = f2a((t1 * c - t2 * s) * sc); q[32 + i] = f2a((t1 * s + t2 * c) * sc);
    }
}
DEV void ph_conv(const P& p, int layer, long gtid, long gsz) {
    ITEMS((long)T * XBC) {
        const int c = (int)(it % XBC); const long t = it / XBC; const int l = (int)(t % L);
        float acc = p.conv_b[layer * XBC + c];
        for (int w = 0; w < 4; ++w) { const int ll = l - 3 + w; if (ll >= 0) acc += a2f(p.u[(size_t)(t - 3 + w) * UN + U_XS + c]) * p.conv_w[((size_t)layer * 4 + w) * XBC + c]; }
        p.xbc[it] = f2a(siluf(acc));
    }
}
DEV void ph_dt(const P& p, int layer, long gtid, long gsz) {
    ITEMS(NB * NCH * 8) {
        const int hd = (int)(it % 8); const long bc = it / 8;
        const float bias = p.dt_bias[layer * 8 + hd], A = -expf(p.a_log[layer * 8 + hd]);
        float cs = 0.f;
        for (int i = 0; i < CH; ++i) { const long t = bc * CH + i; const float dt = softplusf(p.dtraw[t * 8 + hd] + bias); cs += A * dt; p.dt[t * 8 + hd] = dt; p.acs[t * 8 + hd] = cs; }
        p.cdec[it] = expf(cs);
    }
}
DEV void ph_ret_state(const P& p, long gtid, long gsz) {
    ITEMS((long)NB * NCH * 4 * 4096) {
        const int e = (int)(it % 64), d = (int)((it / 64) % 64), h = (int)((it / 4096) % 4); const long bc = it / (4096 * 4);
        const float lg = loggamma(h); float acc = 0.f;
        for (int j = 0; j < CH; ++j) { const act_t* r = p.u + (size_t)(bc * CH + j) * UN; acc += a2f(r[U_RK + h * 64 + d]) * expf(lg * (float)(CH - 1 - j)) * a2f(r[U_RV + h * 64 + e]); }
        p.st_ret[it] = acc;
    }
}
DEV void ph_ssd_state(const P& p, long gtid, long gsz) {
    ITEMS((long)NB * NCH * 8 * 4096) {
        const int n = (int)(it % 64), pp = (int)((it / 64) % 64), hd = (int)((it / 4096) % 8); const long bc = it / (4096 * 8); const int g = hd / 4;
        const float alast = p.acs[(bc * CH + CH - 1) * 8 + hd]; float acc = 0.f;
        for (int l = 0; l < CH; ++l) { const long t = bc * CH + l; const act_t* r = p.xbc + (size_t)t * XBC;
            acc += a2f(r[512 + g * 64 + n]) * expf(alast - p.acs[t * 8 + hd]) * (a2f(r[hd * 64 + pp]) * p.dt[t * 8 + hd]); }
        p.st_ssd[it] = acc;
    }
}
DEV void ph_scan(const P& p, long gtid, long gsz) {
    ITEMS((long)NB * 4 * 4096 + (long)NB * 8 * 4096) {
        if (it < (long)NB * 4 * 4096) {
            const int el = (int)(it % 4096), h = (int)((it / 4096) % 4), b = (int)(it / (4096 * 4));
            const float dec = expf(loggamma(h) * (float)CH); float S = 0.f;
            for (int c = 0; c < NCH; ++c) { float* q = p.st_ret + (((size_t)b * NCH + c) * 4 + h) * 4096 + el; const float v = *q; *q = S; S = dec * S + v; }
        } else {
            const long i2 = it - (long)NB * 4 * 4096; const int el = (int)(i2 % 4096), hd = (int)((i2 / 4096) % 8), b = (int)(i2 / (4096 * 8));
            float S = 0.f;
            for (int c = 0; c < NCH; ++c) { float* q = p.st_ssd + (((size_t)b * NCH + c) * 8 + hd) * 4096 + el; const float v = *q; *q = S; S = p.cdec[((size_t)b * NCH + c) * 8 + hd] * S + v; }
        }
    }
}
DEV void ph_ret_o(const P& p, long gtid, long gsz) {
    ITEMS((long)T * 256) {
        const int e = (int)(it % 64), h = (int)((it / 64) % 4); const long t = it / 256; const int i = (int)(t % CH); const long bc = t / CH;
        const float lg = loggamma(h); const act_t* qi = p.u + (size_t)t * UN + U_RQ + h * 64;
        float acc = 0.f;
        for (int j = 0; j <= i; ++j) { const act_t* r = p.u + (size_t)(bc * CH + j) * UN; float s = 0.f;
            for (int d = 0; d < 64; ++d) s += a2f(qi[d]) * a2f(r[U_RK + h * 64 + d]);
            acc += s * expf(lg * (float)(i - j)) * a2f(r[U_RV + h * 64 + e]); }
        const float* pv = p.st_ret + ((size_t)bc * 4 + h) * 4096; float cr = 0.f;
        for (int d = 0; d < 64; ++d) cr += a2f(qi[d]) * pv[d * 64 + e];
        p.oraw[it] = acc + expf(lg * (float)(i + 1)) * cr;
    }
}
DEV void ph_ret_norm(const P& p, long gtid, long gsz) {
    ITEMS((long)T * 4) {
        const int h = (int)(it % 4); const long t = it / 4; const float* o = p.oraw + t * 256 + h * 64;
        float mu = 0.f; for (int e = 0; e < 64; ++e) mu += o[e]; mu *= (1.0f / 64.0f);
        float var = 0.f; for (int e = 0; e < 64; ++e) { const float dlt = o[e] - mu; var += dlt * dlt; } var *= (1.0f / 64.0f);
        const float rs = 1.0f / sqrtf(var + LN_EPS);
        for (int e = 0; e < 64; ++e) { const float g = a2f(p.u[(size_t)t * UN + U_RG + h * 64 + e]); p.ymix[(size_t)t * D + h * 64 + e] = f2a(siluf(g) * ((o[e] - mu) * rs)); }
    }
}
DEV void ph_ssd_y(const P& p, int layer, long gtid, long gsz) {
    ITEMS((long)T * 512) {
        const int pp = (int)(it % 64), hd = (int)((it / 64) % 8); const long t = it / 512; const int l = (int)(t % CH); const long bc = t / CH; const int g = hd / 4;
        const act_t* rl = p.xbc + (size_t)t * XBC; const float al = p.acs[t * 8 + hd];
        float acc = 0.f;
        for (int s = 0; s <= l; ++s) { const long ts = bc * CH + s; const act_t* rs = p.xbc + (size_t)ts * XBC; float cb = 0.f;
            for (int n = 0; n < 64; ++n) cb += a2f(rl[640 + g * 64 + n]) * a2f(rs[512 + g * 64 + n]);
            acc += cb * expf(al - p.acs[ts * 8 + hd]) * (a2f(rs[hd * 64 + pp]) * p.dt[ts * 8 + hd]); }
        const float* pv = p.st_ssd + ((size_t)bc * 8 + hd) * 4096 + pp * 64; float off = 0.f;
        for (int n = 0; n < 64; ++n) off += a2f(rl[640 + g * 64 + n]) * pv[n];
        p.yraw[it] = acc + off * expf(al) + a2f(rl[hd * 64 + pp]) * p.d_skip[layer * 8 + hd];
    }
}
DEV void ph_ssd_norm(const P& p, int layer, long gtid, long gsz) {
    ITEMS((long)T * 2) {
        const int g = (int)(it % 2); const long t = it / 2;
        float ms = 0.f;
        for (int k = 0; k < 256; ++k) { const int ch = g * 256 + k; const float hv = p.yraw[t * 512 + ch] * siluf(a2f(p.u[(size_t)t * UN + U_SZ + ch])); ms += hv * hv; }
        const float rs = 1.0f / sqrtf(ms * (1.0f / 256.0f) + LN_EPS);
        for (int k = 0; k < 256; ++k) { const int ch = g * 256 + k; const float hv = p.yraw[t * 512 + ch] * siluf(a2f(p.u[(size_t)t * UN + U_SZ + ch]));
            p.ymix[(size_t)t * D + 256 + ch] = f2a(hv * rs * p.ssd_norm_w[layer * 512 + ch]); }
    }
}
DEV void ph_swa(const P& p, int layer, long gtid, long gsz) {
    ITEMS((long)T * 256) {
        const int d = (int)(it % 64), hq = (int)((it / 64) % 4); const long t = it / 256; const int l = (int)(t % L); const int kvh = hq / 2;
        const act_t* q = p.u + (size_t)t * UN + U_AQ + hq * 64;
        float m = p.sinks[layer * 4 + hq], den = 1.0f, acc = 0.f;
        const int j0 = l - 127 > 0 ? l - 127 : 0;
        for (int j = j0; j <= l; ++j) { const act_t* r = p.u + (size_t)(t - l + j) * UN; float s = 0.f;
            for (int dd = 0; dd < 64; ++dd) s += a2f(q[dd]) * a2f(r[U_AK + kvh * 64 + dd]);
            s = s * 0.125f + p.rel_bias[T5B[l - j] * 4 + hq];
            if (s > m) { const float sc = expf(m - s); den *= sc; acc *= sc; m = s; }
            const float pr = expf(s - m); den += pr; acc += pr * a2f(r[U_AV + kvh * 64 + d]); }
        p.ymix[(size_t)t * D + 768 + hq * 64 + d] = f2a(acc / den);
    }
}
DEV int moe_rb(const P& p, int e) { int acc = 0; for (int k = 0; k < NE; ++k) if (k < e) acc += (p.cnt[k] + 255) / 256 * 256; return acc; }
DEV float ln_fval(const P& p, int fsrc, long t, int d, size_t r0, size_t r1) {
    if (fsrc == 0) return p.gout[t * D + d];
    return p.top_w[t * 2] * a2f(p.ybuf[r0 * D + d]) + p.top_w[t * 2 + 1] * a2f(p.ybuf[r1 * D + d]);
}
DEV void ph_ln(const P& p, int layer, int which, const float* xin, float* xout, int fsrc, int hl, int hsel, long gtid, long gsz) {
    ITEMS(T) {
        const long t = it; const int b = (int)(t / L);
        size_t r0 = 0, r1 = 0; if (fsrc == 1) { r0 = (size_t)moe_rb(p, p.top_e[t * 2]) + p.top_p[t * 2]; r1 = (size_t)moe_rb(p, p.top_e[t * 2 + 1]) + p.top_p[t * 2 + 1]; }
        const float* gate = p.mod + ((size_t)layer * NB + b) * 6 * D + (which ? 5 : 2) * D;
        float mu = 0.f; for (int d = 0; d < D; ++d) mu += ALPHA * xin[t * D + d] + (1.0f + gate[d]) * ln_fval(p, fsrc, t, d, r0, r1); mu *= (1.0f / D);
        float var = 0.f; for (int d = 0; d < D; ++d) { const float v = ALPHA * xin[t * D + d] + (1.0f + gate[d]) * ln_fval(p, fsrc, t, d, r0, r1) - mu; var += v * v; } var *= (1.0f / D);
        const float rs = 1.0f / sqrtf(var + LN_EPS);
        const float* lg = p.ln_g + ((size_t)layer * 2 + which) * D; const float* lb = p.ln_b + ((size_t)layer * 2 + which) * D;
        const float* m = hl >= 0 ? p.mod + ((size_t)hl * NB + b) * 6 * D + hsel * 3 * D : nullptr;
        for (int d = 0; d < D; ++d) { const float v = ALPHA * xin[t * D + d] + (1.0f + gate[d]) * ln_fval(p, fsrc, t, d, r0, r1);
            const float o = (v - mu) * rs * lg[d] + lb[d]; xout[t * D + d] = o;
            if (m) p.hb[t * D + d] = f2a(o * (1.0f + m[D + d]) + m[d]); }
    }
}
DEV void ph_route(const P& p, int layer, const float* xin, long gtid, long gsz) {
    ITEMS(T) {
        const long t = it; const int b = (int)(t / L);
        const float* m = p.mod + ((size_t)layer * NB + b) * 6 * D + 3 * D;
        float lg0 = 0, lg1 = 0, lg2 = 0, lg3 = 0, lg4 = 0, lg5 = 0, lg6 = 0, lg7 = 0;
        for (int d = 0; d < D; ++d) { const float hv = xin[t * D + d] * (1.0f + m[D + d]) + m[d]; const float* w = p.router_w + (size_t)d * NE;
            lg0 += hv * w[0]; lg1 += hv * w[1]; lg2 += hv * w[2]; lg3 += hv * w[3]; lg4 += hv * w[4]; lg5 += hv * w[5]; lg6 += hv * w[6]; lg7 += hv * w[7]; }
        float v1 = -3.0e38f, v2 = -3.0e38f; int i1 = 0, i2 = 0;
#define RT_STEP(e, val) { const float vv = (val) + p.router_b[e]; if (vv > v1) { v2 = v1; i2 = i1; v1 = vv; i1 = e; } else if (vv > v2) { v2 = vv; i2 = e; } }
        RT_STEP(0, lg0) RT_STEP(1, lg1) RT_STEP(2, lg2) RT_STEP(3, lg3) RT_STEP(4, lg4) RT_STEP(5, lg5) RT_STEP(6, lg6) RT_STEP(7, lg7)
#undef RT_STEP
        const float w1 = 1.0f / (1.0f + expf(v2 - v1));
        const int p1 = atomic_inc(p.cnt + i1), p2 = atomic_inc(p.cnt + i2);
        p.slot_tok[(size_t)i1 * T + p1] = (int)t; p.slot_tok[(size_t)i2 * T + p2] = (int)t;
        p.top_e[t * 2] = i1; p.top_e[t * 2 + 1] = i2; p.top_p[t * 2] = p1; p.top_p[t * 2 + 1] = p2; p.top_w[t * 2] = w1; p.top_w[t * 2 + 1] = 1.0f - w1;
    }
}

struct GG { const act_t* A; int lda; const int* gather; int M; const float* B; const float* B2; int ldb; int skip_at, skip_by; int K; void* C; int ldc; int mode; };
#ifdef CPU_EMU
static void gg_tile(const GG& g, int mt, int nt) {
    for (int r = 0; r < 128; ++r) { const int m = mt * 128 + r; if (m >= g.M) break; const int ar = g.gather ? g.gather[m] : m;
        for (int cc = 0; cc < 64; ++cc) { const int n = nt * 64 + cc, bc = n >= g.skip_at ? n + g.skip_by : n; float a1 = 0.f, a2 = 0.f;
            for (int k = 0; k < g.K; ++k) { const float av = g.A[(size_t)ar * g.lda + k]; a1 += av * g.B[(size_t)k * g.ldb + bc]; if (g.mode == 2) a2 += av * g.B2[(size_t)k * g.ldb + bc]; }
            if (g.mode == 0) ((float*)g.C)[(size_t)m * g.ldc + n] = a1; else ((act_t*)g.C)[(size_t)m * g.ldc + n] = f2a(g.mode == 2 ? siluf(a1) * a2 : a1); } }
}
#else
__device__ __forceinline__ void gg_tile(const GG& g, int mt, int nt, float* sm) {
    float* As = sm; float* Bs = sm + 16 * 132; float* B2s = Bs + 16 * 64;
    const int tid = threadIdx.x, ty = tid >> 4, tx = tid & 15;
    float a1[4][4], a2[4][4];
#pragma unroll
    for (int i = 0; i < 4; ++i)
#pragma unroll
        for (int j = 0; j < 4; ++j) { a1[i][j] = 0.f; a2[i][j] = 0.f; }
    const int ar_ = tid >> 2, ak_ = (tid & 3) * 4; const int am = mt * 128 + ar_; const bool aval = am < g.M;
    const int arow = aval ? (g.gather ? g.gather[am] : am) : 0;
    const act_t* Ap = g.A + (size_t)arow * g.lda + ak_;
    const int bk_ = tid >> 5, bn_ = (tid & 31) * 2; const int n0 = nt * 64 + bn_;
    const int bc0 = n0 >= g.skip_at ? n0 + g.skip_by : n0, bc1 = (n0 + 1) >= g.skip_at ? n0 + 1 + g.skip_by : n0 + 1;
    for (int k0 = 0; k0 < g.K; k0 += 16) {
#pragma unroll
        for (int i = 0; i < 4; ++i) As[(ak_ + i) * 132 + ar_] = aval ? a2f(Ap[k0 + i]) : 0.f;
        const float* bp = g.B + (size_t)(k0 + bk_) * g.ldb; Bs[bk_ * 64 + bn_] = bp[bc0]; Bs[bk_ * 64 + bn_ + 1] = bp[bc1];
        if (g.mode == 2) { const float* bp2 = g.B2 + (size_t)(k0 + bk_) * g.ldb; B2s[bk_ * 64 + bn_] = bp2[bc0]; B2s[bk_ * 64 + bn_ + 1] = bp2[bc1]; }
        __syncthreads();
#pragma unroll
        for (int k = 0; k < 16; ++k) {
            float av[4], bv[4], cv[4];
#pragma unroll
            for (int i = 0; i < 4; ++i) { av[i] = As[k * 132 + ty * 4 + i]; bv[i] = Bs[k * 64 + tx * 4 + i]; cv[i] = g.mode == 2 ? B2s[k * 64 + tx * 4 + i] : 0.f; }
#pragma unroll
            for (int i = 0; i < 4; ++i)
#pragma unroll
                for (int j = 0; j < 4; ++j) { a1[i][j] += av[i] * bv[j]; if (g.mode == 2) a2[i][j] += av[i] * cv[j]; }
        }
        __syncthreads();
    }
#pragma unroll
    for (int i = 0; i < 4; ++i) { const int m = mt * 128 + ty * 4 + i; if (m < g.M) {
#pragma unroll
        for (int j = 0; j < 4; ++j) { const int n = nt * 64 + tx * 4 + j;
            if (g.mode == 0) ((float*)g.C)[(size_t)m * g.ldc + n] = a1[i][j]; else ((act_t*)g.C)[(size_t)m * g.ldc + n] = f2a(g.mode == 2 ? siluf(a1[i][j]) * a2[i][j] : a1[i][j]); } } }
}
#endif

#ifdef CPU_EMU
#define GG_TILE(g, mt, nt) gg_tile(g, mt, nt)
#define SM_ARG
#define SM_PARM
#else
#define GG_TILE(g, mt, nt) gg_tile(g, mt, nt, sm)
#define SM_ARG , sm
#define SM_PARM , float* sm
#endif
DEV void ph_gemm_plain(const GG& g, int N, int bid, int nblk SM_PARM) {
    const int ntn = N / 64, ntm = (g.M + 127) / 128;
    for (int tIdx = bid; tIdx < ntn * ntm; tIdx += nblk) GG_TILE(g, tIdx / ntn, tIdx % ntn);
}
DEV void ph_gemm_moe(const P& p, int which, int pass, int bid, int nblk SM_PARM) {
    const int N = which ? D : DFFE, ntn = N / 64, ntm = T / 128;
    for (long tIdx = bid; tIdx < (long)NE * ntm * ntn; tIdx += nblk) {
        const int nt = (int)(tIdx % ntn), mt = (int)((tIdx / ntn) % ntm), e = (int)(tIdx / ((long)ntn * ntm));
        if (mt * 128 >= p.cnt[e]) continue;
        const int rbe = moe_rb(p, e); const ptrdiff_t arow0 = (ptrdiff_t)rbe - (ptrdiff_t)pass * CAPR;
        const int grow = rbe + mt * 128;
        if (grow < pass * CAPR || grow >= (pass + 1) * CAPR) continue;
        GG g;
        if (which == 0) { g.A = p.hb; g.lda = D; g.gather = p.slot_tok + (size_t)e * T; g.M = p.cnt[e]; g.B = p.ex_wg + (size_t)e * D * DFFE; g.B2 = p.ex_wu + (size_t)e * D * DFFE; g.ldb = DFFE;
            g.skip_at = 1 << 30; g.skip_by = 0; g.K = D; g.C = p.act + arow0 * DFFE; g.ldc = DFFE; g.mode = 2; }
        else { g.A = p.act + arow0 * DFFE; g.lda = DFFE; g.gather = nullptr; g.M = p.cnt[e]; g.B = p.ex_wd + (size_t)e * DFFE * D; g.B2 = nullptr; g.ldb = D;
            g.skip_at = 1 << 30; g.skip_by = 0; g.K = DFFE; g.C = p.ybuf + (size_t)rbe * D; g.ldc = D; g.mode = 1; }
        GG_TILE(g, mt, nt);
    }
}

constexpr size_t al256(size_t v) { return (v + 255) & ~(size_t)255; }
struct WsMap {
    size_t mod, cs, hb, u, dtraw, dt, acs, xbc, st_ret, st_ssd, cdec, oraw, yraw, ymix, gout, xb, act, ybuf, cnt, slot_tok, top_e, top_p, top_w, end;
};
static WsMap make_map() {
    WsMap m; size_t o = 0;
    const size_t A = sizeof(act_t);
    m.cnt = o; o += CTL_BYTES;
    m.mod = o; o += al256((size_t)2 * NB * 6 * D * 4);
    m.cs = o; o += al256((size_t)T * 64 * 4);
    m.hb = o; o += al256((size_t)T * D * A);
    m.dtraw = o; o += al256((size_t)T * 8 * 4);
    m.dt = o; o += al256((size_t)T * 8 * 4);
    m.acs = o; o += al256((size_t)T * 8 * 4);
    m.cdec = o; o += al256((size_t)NB * NCH * 8 * 4);
    m.gout = o; o += al256((size_t)T * D * 4);
    m.xb = o; o += al256((size_t)T * D * 4);
    m.slot_tok = o; o += al256((size_t)NE * T * 4);
    m.top_e = o; o += al256((size_t)T * 2 * 4);
    m.top_p = o; o += al256((size_t)T * 2 * 4);
    m.top_w = o; o += al256((size_t)T * 2 * 4);
    const size_t r1 = o; size_t r1e = r1;
    m.u = r1; m.ymix = r1 + al256((size_t)T * UN * A); r1e = m.ymix + al256((size_t)T * D * A);
    m.act = r1; { size_t e1 = r1 + al256((size_t)T * DFF * A); if (e1 > r1e) r1e = e1; size_t e2 = r1 + al256((size_t)CAPR * DFFE * A); if (e2 > r1e) r1e = e2; }
    o = r1e;
    const size_t r2 = o; size_t q = r2;
    m.xbc = q; q += al256((size_t)T * XBC * A);
    m.st_ret = q; q += al256((size_t)NB * NCH * 4 * 4096 * 4);
    m.st_ssd = q; q += al256((size_t)NB * NCH * 8 * 4096 * 4);
    m.oraw = q; q += al256((size_t)T * 256 * 4);
    m.yraw = q; q += al256((size_t)T * 512 * 4);
    m.ybuf = r2; { size_t e = r2 + al256((size_t)MAXROWS * D * A); if (e > q) q = e; }
    o = q;
    m.end = o;
    return m;
}

static void fill_params(P& p, void* const* d_in, void* d_out, void* d_ws, const WsMap& m) {
    p.x = (const float*)d_in[0]; p.c = (const float*)d_in[1]; p.pos = (const int*)d_in[2]; p.rel_bias = (const float*)d_in[3]; p.w_ada = (const float*)d_in[4]; p.b_ada = (const float*)d_in[5];
    p.w_in = (const float*)d_in[6]; p.w_out = (const float*)d_in[7]; p.conv_w = (const float*)d_in[8]; p.conv_b = (const float*)d_in[9]; p.dt_bias = (const float*)d_in[10]; p.a_log = (const float*)d_in[11];
    p.d_skip = (const float*)d_in[12]; p.ssd_norm_w = (const float*)d_in[13]; p.sinks = (const float*)d_in[14]; p.ln_g = (const float*)d_in[15]; p.ln_b = (const float*)d_in[16];
    p.ffn_wg = (const float*)d_in[17]; p.ffn_wu = (const float*)d_in[18]; p.ffn_wd = (const float*)d_in[19]; p.router_w = (const float*)d_in[20]; p.router_b = (const float*)d_in[21];
    p.ex_wg = (const float*)d_in[22]; p.ex_wu = (const float*)d_in[23]; p.ex_wd = (const float*)d_in[24];
    p.out = (float*)d_out;
    char* w = (char*)d_ws;
    p.mod = (float*)(w + m.mod); p.cs = (float*)(w + m.cs); p.hb = (act_t*)(w + m.hb); p.u = (act_t*)(w + m.u); p.dtraw = (float*)(w + m.dtraw); p.dt = (float*)(w + m.dt); p.acs = (float*)(w + m.acs);
    p.xbc = (act_t*)(w + m.xbc); p.st_ret = (float*)(w + m.st_ret); p.st_ssd = (float*)(w + m.st_ssd); p.cdec = (float*)(w + m.cdec); p.oraw = (float*)(w + m.oraw); p.yraw = (float*)(w + m.yraw);
    p.ymix = (act_t*)(w + m.ymix); p.gout = (float*)(w + m.gout); p.xb = (float*)(w + m.xb); p.act = (act_t*)(w + m.act); p.ybuf = (act_t*)(w + m.ybuf);
    p.cnt = (int*)(w + m.cnt); p.bar = (unsigned*)(w + m.cnt + CTL_BAR_OFF); p.slot_tok = (int*)(w + m.slot_tok); p.top_e = (int*)(w + m.top_e); p.top_p = (int*)(w + m.top_p); p.top_w = (float*)(w + m.top_w);
}

enum { PH_MOD = 0, PH_ROTAB, PH_MODUL0, PH_DTRAW, PH_INPROJ, PH_ROTARY, PH_CONV, PH_DT, PH_RSTATE, PH_SSTATE, PH_SCAN, PH_RETO, PH_RETN, PH_SSDY, PH_SSDN, PH_SWA, PH_OUTPROJ, PH_LN1,
       PH_FFN_GU, PH_FFN_DN, PH_LN2, PH_ROUTE, PH_MOE_GU0, PH_MOE_DN0, PH_MOE_GU1, PH_MOE_DN1, PH_LN2M };

template <int ph> DEV void run_phase(const P& p, int layer, long gtid, long gsz, int bid, int nblk SM_PARM) {
    const float* xin = layer == 0 ? p.x : p.xb;
    float* x1 = p.out;
    if constexpr (ph == PH_MOD) ph_mod(p, gtid, gsz);
    if constexpr (ph == PH_ROTAB) ph_rotab(p, gtid, gsz);
    if constexpr (ph == PH_MODUL0) ph_modulate(p, 0, p.x, 0, gtid, gsz);
    if constexpr (ph == PH_DTRAW) ph_dtraw(p, layer, xin, gtid, gsz);
    if constexpr (ph == PH_INPROJ) { GG g; g.A = p.hb; g.lda = D; g.gather = nullptr; g.M = T; g.B = p.w_in + (size_t)layer * D * IN_DIM; g.B2 = nullptr; g.ldb = IN_DIM; g.skip_at = W_DT; g.skip_by = 8; g.K = D; g.C = p.u; g.ldc = UN; g.mode = 1;
        ph_gemm_plain(g, UN, bid, nblk SM_ARG); }
    if constexpr (ph == PH_ROTARY) ph_rotary(p, gtid, gsz);
    if constexpr (ph == PH_CONV) ph_conv(p, layer, gtid, gsz);
    if constexpr (ph == PH_DT) ph_dt(p, layer, gtid, gsz);
    if constexpr (ph == PH_RSTATE) ph_ret_state(p, gtid, gsz);
    if constexpr (ph == PH_SSTATE) ph_ssd_state(p, gtid, gsz);
    if constexpr (ph == PH_SCAN) ph_scan(p, gtid, gsz);
    if constexpr (ph == PH_RETO) ph_ret_o(p, gtid, gsz);
    if constexpr (ph == PH_RETN) ph_ret_norm(p, gtid, gsz);
    if constexpr (ph == PH_SSDY) ph_ssd_y(p, layer, gtid, gsz);
    if constexpr (ph == PH_SSDN) ph_ssd_norm(p, layer, gtid, gsz);
    if constexpr (ph == PH_SWA) ph_swa(p, layer, gtid, gsz);
    if constexpr (ph == PH_OUTPROJ) { GG g; g.A = p.ymix; g.lda = D; g.gather = nullptr; g.M = T; g.B = p.w_out + (size_t)layer * D * D; g.B2 = nullptr; g.ldb = D; g.skip_at = 1 << 30; g.skip_by = 0; g.K = D; g.C = p.gout; g.ldc = D; g.mode = 0;
        ph_gemm_plain(g, D, bid, nblk SM_ARG); }
    if constexpr (ph == PH_LN1) ph_ln(p, layer, 0, xin, x1, 0, layer, 1, gtid, gsz);
    if constexpr (ph == PH_FFN_GU) { GG g; g.A = p.hb; g.lda = D; g.gather = nullptr; g.M = T; g.B = p.ffn_wg; g.B2 = p.ffn_wu; g.ldb = DFF; g.skip_at = 1 << 30; g.skip_by = 0; g.K = D; g.C = p.act; g.ldc = DFF; g.mode = 2;
        ph_gemm_plain(g, DFF, bid, nblk SM_ARG); }
    if constexpr (ph == PH_FFN_DN) { GG g; g.A = p.act; g.lda = DFF; g.gather = nullptr; g.M = T; g.B = p.ffn_wd; g.B2 = nullptr; g.ldb = D; g.skip_at = 1 << 30; g.skip_by = 0; g.K = DFF; g.C = p.gout; g.ldc = D; g.mode = 0;
        ph_gemm_plain(g, D, bid, nblk SM_ARG); }
    if constexpr (ph == PH_LN2) ph_ln(p, layer, 1, x1, p.xb, 0, 1, 0, gtid, gsz);
    if constexpr (ph == PH_ROUTE) ph_route(p, layer, x1, gtid, gsz);
    if constexpr (ph == PH_MOE_GU0) ph_gemm_moe(p, 0, 0, bid, nblk SM_ARG);
    if constexpr (ph == PH_MOE_DN0) ph_gemm_moe(p, 1, 0, bid, nblk SM_ARG);
    if constexpr (ph == PH_MOE_GU1) ph_gemm_moe(p, 0, 1, bid, nblk SM_ARG);
    if constexpr (ph == PH_MOE_DN1) ph_gemm_moe(p, 1, 1, bid, nblk SM_ARG);
    if constexpr (ph == PH_LN2M) ph_ln(p, layer, 1, x1, p.out, 1, -1, 0, gtid, gsz);
}

static const int PROGRAM[][2] = {
    {PH_MOD, 0}, {PH_ROTAB, 0}, {PH_MODUL0, 0},
    {PH_DTRAW, 0}, {PH_INPROJ, 0}, {PH_ROTARY, 0}, {PH_CONV, 0}, {PH_DT, 0}, {PH_RSTATE, 0}, {PH_SSTATE, 0}, {PH_SCAN, 0}, {PH_RETO, 0}, {PH_RETN, 0}, {PH_SSDY, 0}, {PH_SSDN, 0}, {PH_SWA, 0},
    {PH_OUTPROJ, 0}, {PH_LN1, 0}, {PH_FFN_GU, 0}, {PH_FFN_DN, 0}, {PH_LN2, 0},
    {PH_DTRAW, 1}, {PH_INPROJ, 1}, {PH_ROTARY, 1}, {PH_CONV, 1}, {PH_DT, 1}, {PH_RSTATE, 1}, {PH_SSTATE, 1}, {PH_SCAN, 1}, {PH_RETO, 1}, {PH_RETN, 1}, {PH_SSDY, 1}, {PH_SSDN, 1}, {PH_SWA, 1},
    {PH_OUTPROJ, 1}, {PH_LN1, 1}, {PH_ROUTE, 1}, {PH_MOE_GU0, 1}, {PH_MOE_DN0, 1}, {PH_MOE_GU1, 1}, {PH_MOE_DN1, 1}, {PH_LN2M, 1},
};
constexpr int NPROG = sizeof(PROGRAM) / sizeof(PROGRAM[0]);

#ifndef CPU_EMU
#define XB_TMO      128
#define XB_XCNT(j)  (256  + 64 * (j))
#define XB_XSUB(j)  (1280 + 64 * (j))
#define XB_XGEN(j)  (2304 + 64 * (j))
#define XB_TOP      3328
#define XB_TOPGEN   3392
#define XCD_BAR_WORDS 3456
#define XB_SPIN_CAP (1u << 18)
#define LAS __attribute__((address_space(3)))

__device__ __forceinline__ unsigned xb_ld(unsigned* p)              { return __hip_atomic_load(p, __ATOMIC_RELAXED, __HIP_MEMORY_SCOPE_AGENT); }
__device__ __forceinline__ unsigned xb_add(unsigned* p, unsigned v) { return __hip_atomic_fetch_add(p, v, __ATOMIC_RELAXED, __HIP_MEMORY_SCOPE_AGENT); }
__device__ __forceinline__ unsigned xb_xcc_id() { return (unsigned)__builtin_amdgcn_s_getreg((3 << 11) | 20) & 0xFu; }
#define XB_SPIN(cond, bar) do { unsigned _sp = 0; while (cond) { __builtin_amdgcn_s_sleep(1); \
    if ((++_sp & 255u) == 0u) { if (xb_ld(&(bar)[XB_TMO])) break; if (_sp > XB_SPIN_CAP) { atomicAdd(&(bar)[XB_TMO], 1u); break; } } } } while (0)

struct XcdBarrier {
    unsigned* bar; unsigned x;
    volatile LAS unsigned* st;
};
__device__ __forceinline__ XcdBarrier xcd_barrier_post(unsigned* bar, volatile LAS unsigned* st) {
    XcdBarrier b; b.bar = bar; b.x = xb_xcc_id(); b.st = st;
    if (threadIdx.x == 0) (void)xb_add(&bar[XB_XCNT(b.x)], 1u);
    return b;
}
__device__ __forceinline__ void xcd_barrier_complete(unsigned* bar, unsigned x, unsigned& nloc, unsigned& nx) {
    const unsigned G = gridDim.x * gridDim.y * gridDim.z;
    unsigned sum, cnt, mine, sp = 0u;
    for (;;) {
        sum = 0u; cnt = 0u; mine = 0u;
#pragma unroll
        for (unsigned j = 0; j < 16; ++j) { const unsigned c = xb_ld(&bar[XB_XCNT(j)]); sum += c; cnt += (c > 0u) ? 1u : 0u; mine = (j == x) ? c : mine; }
        if (sum == G) break;
        __builtin_amdgcn_s_sleep(1);
        if ((++sp & 255u) == 0u) { if (xb_ld(&bar[XB_TMO])) break; if (sp > XB_SPIN_CAP) { atomicAdd(&bar[XB_TMO], 1u); break; } }
    }
    nloc = mine > 0u ? mine : 1u; nx = cnt > 0u ? cnt : 1u;
}
__device__ __forceinline__ void xcd_barrier(const XcdBarrier& b) {
    asm volatile("s_waitcnt vmcnt(0)" ::: "memory");
    __syncthreads();
    if (threadIdx.x == 0) {
        unsigned* bar = b.bar;
        __builtin_amdgcn_s_waitcnt(0);
        unsigned nloc = b.st[0], nx = b.st[1];
        if (nloc == 0u) { xcd_barrier_complete(bar, b.x, nloc, nx); b.st[0] = nloc; b.st[1] = nx; }
        const unsigned old = xb_add(&bar[XB_XSUB(b.x)], 1u);
        const unsigned gen = old / nloc;
        if (old + 1u == (gen + 1u) * nloc) {
            __builtin_amdgcn_fence(__ATOMIC_RELEASE, "agent");
            asm volatile("s_waitcnt vmcnt(0)" ::: "memory");
            const unsigned og = xb_add(&bar[XB_TOP], 1u);
            const unsigned tg = og / nx;
            if (og + 1u == (tg + 1u) * nx) xb_add(&bar[XB_TOPGEN], 1u);
            else XB_SPIN(xb_ld(&bar[XB_TOPGEN]) == tg, bar);
            __builtin_amdgcn_fence(__ATOMIC_ACQUIRE, "agent");
            xb_add(&bar[XB_XGEN(b.x)], 1u);
            asm volatile("s_waitcnt vmcnt(0)" ::: "memory");
        } else {
            XB_SPIN(xb_ld(&bar[XB_XGEN(b.x)]) == gen, bar);
            __builtin_amdgcn_fence(__ATOMIC_ACQUIRE, "agent");
            asm volatile("s_waitcnt vmcnt(0)" ::: "memory");
        }
    }
    __syncthreads();
}

constexpr int LDS_BYTES = 147456, LDS_CTL_OFF = 131072, LDS_BAR_OFF = LDS_CTL_OFF + 64;
__global__ void __launch_bounds__(512, 2) mk_fwd(P p) {
    extern __shared__ __attribute__((aligned(16))) unsigned char lds[];
    for (int w = threadIdx.x; w < (LDS_BYTES - LDS_CTL_OFF) / 4; w += 512) ((LAS unsigned*)(lds + LDS_CTL_OFF))[w] = 0u;
    __syncthreads();
    XcdBarrier bar = xcd_barrier_post(p.bar, (volatile LAS unsigned*)(lds + LDS_BAR_OFF));
    float* sm = (float*)lds;
    const long gtid = (long)blockIdx.x * 512 + threadIdx.x, gsz = (long)gridDim.x * 512; const int bid = blockIdx.x, nblk = gridDim.x;
#define PH(id, layer) run_phase<id>(p, layer, gtid, gsz, bid, nblk, sm)
#define BAR() xcd_barrier(bar)
    PH(PH_MOD, 0); PH(PH_ROTAB, 0); BAR();
    PH(PH_MODUL0, 0); BAR();
#define MIXER(layer) \
        PH(PH_DTRAW, layer); PH(PH_INPROJ, layer); BAR(); \
        PH(PH_ROTARY, layer); PH(PH_CONV, layer); PH(PH_DT, layer); BAR(); \
        PH(PH_RSTATE, layer); PH(PH_SSTATE, layer); BAR(); \
        PH(PH_SCAN, layer); BAR(); \
        PH(PH_RETO, layer); PH(PH_SSDY, layer); PH(PH_SWA, layer); BAR(); \
        PH(PH_RETN, layer); PH(PH_SSDN, layer); BAR(); \
        PH(PH_OUTPROJ, layer); BAR(); \
        PH(PH_LN1, layer); BAR();
    MIXER(0)
    PH(PH_FFN_GU, 0); BAR();
    PH(PH_FFN_DN, 0); BAR();
    PH(PH_LN2, 0); BAR();
    MIXER(1)
    PH(PH_ROUTE, 1); BAR();
    PH(PH_MOE_GU0, 1); BAR();
    PH(PH_MOE_DN0, 1); BAR();
    PH(PH_MOE_GU1, 1); BAR();
    PH(PH_MOE_DN1, 1); BAR();
    PH(PH_LN2M, 1);
#undef MIXER
#undef PH
#undef BAR
}

template <int ph> __global__ void __launch_bounds__(512, 2) k_phase(P p, int layer) {
    __shared__ float sm[16 * 132 + 2 * 16 * 64];
    run_phase<ph>(p, layer, (long)blockIdx.x * blockDim.x + threadIdx.x, (long)gridDim.x * blockDim.x, blockIdx.x, gridDim.x, sm);
}
typedef void (*kfn_t)(P, int);
template <int... I> struct KTab { static kfn_t get(int ph) { static const kfn_t tab[] = { k_phase<I>... }; return tab[ph]; } };
typedef KTab<0, 1, 2, 3, 4, 5, 6, 7, 8, 9, 10, 11, 12, 13, 14, 15, 16, 17, 18, 19, 20, 21, 22, 23, 24, 25, 26> KT;

extern "C" void kernel_launch(void* const* d_in, const int* in_sizes, int n_in, void* d_out, int out_size, void* d_ws, size_t ws_size, hipStream_t stream) {
    static WsMap m = make_map();
    if (n_in != 25 || out_size != T * D || ws_size < m.end) { fprintf(stderr, "kernel_launch: unexpected sizes (n_in %d out %d ws %zu need %zu)\n", n_in, out_size, ws_size, m.end); return; }
    P p; memset(&p, 0, sizeof(p)); fill_params(p, d_in, d_out, d_ws, m);
    (void)hipMemsetAsync((char*)d_ws + m.cnt, 0, CTL_BYTES, stream);
#if MK_SINGLE
    static int grid = 0;
    if (grid == 0) {
        int dev = 0, cus = 0, per_cu = 0;
        if (hipGetDevice(&dev) != hipSuccess || hipDeviceGetAttribute(&cus, hipDeviceAttributeMultiprocessorCount, dev) != hipSuccess) { fprintf(stderr, "kernel_launch: device query failed\n"); grid = -1; return; }
        if (hipFuncSetAttribute((const void*)mk_fwd, hipFuncAttributeMaxDynamicSharedMemorySize, LDS_BYTES) != hipSuccess) { fprintf(stderr, "kernel_launch: hipFuncSetAttribute failed\n"); grid = -1; return; }
        if (hipOccupancyMaxActiveBlocksPerMultiprocessor(&per_cu, (const void*)mk_fwd, 512, LDS_BYTES) != hipSuccess || per_cu < 1) { fprintf(stderr, "kernel_launch: occupancy query says %d blocks per CU\n", per_cu); }
        (void)hipGetLastError();
        grid = cus;
    }
    if (grid < 0) return;
    hipLaunchKernelGGL(mk_fwd, dim3(grid), dim3(512), LDS_BYTES, stream, p);
#else
    for (int i = 0; i < NPROG; ++i) hipLaunchKernelGGL(KT::get(PROGRAM[i][0]), dim3(1024), dim3(512), 0, stream, p, PROGRAM[i][1]);
#endif
}
#endif
```

```cpp
#ifndef CPU_EMU
#include <hip/hip_runtime.h>
#endif
#include <stdint.h>
#include <stdio.h>
#include <math.h>
#include <string.h>
#include <stddef.h>

#ifndef SEQ_
#define SEQ_ 8192
#endif
#ifndef DFF_
#define DFF_ 2816
#endif
#ifndef DFFE_
#define DFFE_ 3584
#endif
#ifndef MK_SINGLE
#define MK_SINGLE 1
#endif
constexpr int D = 1024, NB = 2, L = SEQ_, T = NB * L, CH = 128, NCH = L / CH;
constexpr int DFF = DFF_, DFFE = DFFE_, NE = 8;
constexpr int IN_DIM = 2824, UN = 2816, UNP = 3072;
constexpr int U_RQ = 0, U_RK = 256, U_RV = 512, U_RG = 768, U_SZ = 1024, U_XS = 1536, U_AQ = 2304, U_AK = 2560, U_AV = 2688;
constexpr int W_DT = 2304;
constexpr int XBC = 768;
constexpr float LN_EPS = 1e-5f;
constexpr float ALPHA = 1.41421356237309515f;
constexpr int CAPT = 72, CAPR = CAPT * 256;
constexpr size_t CTL_BYTES = 65536, CTL_BAR_OFF = 4096;
constexpr int MAXROWS = (2 * T / 256 + NE) * 256;

#ifdef CPU_EMU
#define DEV static inline
typedef float act_t;
DEV float a2f(act_t v) { return v; }
DEV act_t f2a(float f) { return f; }
DEV int atomic_inc(int* p) { return __sync_fetch_and_add(p, 1); }
#else
#define DEV __device__ __forceinline__
typedef unsigned short act_t;
DEV float a2f(act_t v) { return __uint_as_float(((unsigned)v) << 16); }
DEV act_t f2a(float f) { unsigned u = __float_as_uint(f); return (act_t)((u + 0x7fffu + ((u >> 16) & 1u)) >> 16); }
DEV int atomic_inc(int* p) { return atomicAdd(p, 1); }
#endif

DEV float siluf(float x) { return x / (1.0f + expf(-x)); }
DEV float softplusf(float x) { return x > 20.f ? x : log1pf(expf(x)); }
DEV float loggamma(int h) { return logf(1.0f - exp2f(-5.0f - (float)h)); }

#ifdef CPU_EMU
static const unsigned char
#else
__constant__ unsigned char
#endif
T5B[128] = {0, 1, 2, 3, 4, 5, 6, 7, 8, 9, 10, 11, 12, 13, 14, 15, 16, 16, 16, 17, 17, 18, 18, 18, 19, 19, 19, 20, 20, 20, 20, 21, 21, 21, 21, 22, 22, 22, 22, 22, 23, 23, 23, 23, 23, 23, 24, 24, 24, 24, 24, 24, 25, 25, 25, 25, 25, 25, 25, 26, 26, 26, 26, 26, 26, 26, 26, 27, 27, 27, 27, 27, 27, 27, 27, 27, 27, 28, 28, 28, 28, 28, 28, 28, 28, 28, 28, 29, 29, 29, 29, 29, 29, 29, 29, 29, 29, 29, 29, 30, 30, 30, 30, 30, 30, 30, 30, 30, 30, 30, 30, 30, 30, 31, 31, 31, 31, 31, 31, 31, 31, 31, 31, 31, 31, 31, 31, 31};

struct P {
    const float* x; const float* c; const int* pos; const float* rel_bias; const float* w_ada; const float* b_ada; const float* w_in; const float* w_out;
    const float* conv_w; const float* conv_b; const float* dt_bias; const float* a_log; const float* d_skip; const float* ssd_norm_w; const float* sinks;
    const float* ln_g; const float* ln_b; const float* ffn_wg; const float* ffn_wu; const float* ffn_wd; const float* router_w; const float* router_b;
    const float* ex_wg; const float* ex_wu; const float* ex_wd;
    float* out;
    float* mod;
    float* cs;
    act_t* hb;
    act_t* u;
    float* dtraw;
    float* dt;
    float* acs;
    act_t* xbc;
    float* st_ret;
    float* st_ssd;
    float* cdec;
    act_t* ymix;
    float* gout;
    float* xb;
    act_t* act;
    act_t* ybuf;
    int* cnt;
    int* slot_tok;
    unsigned* bar;
    act_t* win_t; act_t* wout_t; act_t* wgu_t; act_t* wd_t; act_t* egu_t; act_t* ed_t;
    int* top_e;
    int* top_p;
    float* top_w;
};

#define ITEMS(n) for (long it = gtid; it < (long)(n); it += gsz)

DEV void ph_mod(const P& p, long gtid, long gsz) {
    ITEMS(2 * NB * 6 * D) {
        const int n = (int)(it % (6 * D)), b = (int)((it / (6 * D)) % NB), l = (int)(it / (6 * D * NB));
        const float* w = p.w_ada + (size_t)l * D * 6 * D + n; const float* cv = p.c + (size_t)b * D;
        float acc = 0.f;
        for (int k = 0; k < D; ++k) acc += cv[k] * w[(size_t)k * 6 * D];
        p.mod[it] = acc + p.b_ada[l * 6 * D + n];
    }
}
DEV void ph_rotab(const P& p, long gtid, long gsz) {
    ITEMS(T * 32) {
        const int i = (int)(it % 32); const long t = it / 32;
        const float inv = expf((-9.210340371976184f * (float)i) / 32.0f);
        const float ang = (float)p.pos[t] * inv;
        p.cs[t * 64 + i] = (float)cos((double)ang); p.cs[t * 64 + 32 + i] = (float)sin((double)ang);
    }
}
DEV void ph_modulate(const P& p, int layer, const float* xin, int sel, long gtid, long gsz) {
    ITEMS((long)T * D) {
        const int d = (int)(it % D); const long t = it / D; const int b = (int)(t / L);
        const float* m = p.mod + ((size_t)layer * NB + b) * 6 * D + sel * 3 * D;
        p.hb[it] = f2a(xin[it] * (1.0f + m[D + d]) + m[d]);
    }
}
DEV void ph_dtraw(const P& p, int layer, const float* xin, long gtid, long gsz) {
    ITEMS((long)T * 8) {
        const int j = (int)(it % 8); const long t = it / 8; const int b = (int)(t / L);
        const float* m = p.mod + ((size_t)layer * NB + b) * 6 * D; const float* w = p.w_in + (size_t)layer * D * IN_DIM + W_DT + j;
        float acc = 0.f;
        for (int d = 0; d < D; ++d) acc += (xin[t * D + d] * (1.0f + m[D + d]) + m[d]) * w[(size_t)d * IN_DIM];
        p.dtraw[it] = acc;
    }
}
DEV void ph_rotary(const P& p, long gtid, long gsz) {
    ITEMS((long)T * 256) {
        const int i = (int)(it % 32), h = (int)((it / 32) % 4), which = (int)((it / 128) % 2); const long t = it / 256;
        act_t* q = p.u + (size_t)t * UN + (which ? U_RK : U_RQ) + h * 64;
        const float c = p.cs[t * 64 + i], s = p.cs[t * 64 + 32 + i];
        const float t1 = a2f(q[i]), t2 = a2f(q[32 + i]); const float sc = which ? 0.125f : 1.0f;
        q[i] = f2a((t1 * c - t2 * s) * sc); q[32 + i] = f2a((t1 * s + t2 * c) * sc);
    }
}
DEV void ph_conv(const P& p, int layer, long gtid, long gsz) {
    ITEMS((long)T * XBC) {
        const int c = (int)(it % XBC); const long t = it / XBC; const int l = (int)(t % L);
        float acc = p.conv_b[layer * XBC + c];
        for (int w = 0; w < 4; ++w) { const int ll = l - 3 + w; if (ll >= 0) acc += a2f(p.u[(size_t)(t - 3 + w) * UN + U_XS + c]) * p.conv_w[((size_t)layer * 4 + w) * XBC + c]; }
        p.xbc[it] = f2a(siluf(acc));
    }
}
DEV void ph_dt(const P& p, int layer, long gtid, long gsz) {
    ITEMS(NB * NCH * 8) {
        const int hd = (int)(it % 8); const long bc = it / 8;
        const float bias = p.dt_bias[layer * 8 + hd], A = -expf(p.a_log[layer * 8 + hd]);
        float cs = 0.f;
        for (int i = 0; i < CH; ++i) { const long t = bc * CH + i; const float dt = softplusf(p.dtraw[t * 8 + hd] + bias); cs += A * dt; p.dt[t * 8 + hd] = dt; p.acs[t * 8 + hd] = cs; }
        p.cdec[it] = expf(cs);
    }
}
DEV void ph_ret_state(const P& p, long gtid, long gsz) {
    ITEMS((long)NB * NCH * 4 * 4096) {
        const int e = (int)(it % 64), d = (int)((it / 64) % 64), h = (int)((it / 4096) % 4); const long bc = it / (4096 * 4);
        const float lg = loggamma(h); float acc = 0.f;
        for (int j = 0; j < CH; ++j) { const act_t* r = p.u + (size_t)(bc * CH + j) * UN; acc += a2f(r[U_RK + h * 64 + d]) * expf(lg * (float)(CH - 1 - j)) * a2f(r[U_RV + h * 64 + e]); }
        p.st_ret[it] = acc;
    }
}
DEV void ph_ssd_state(const P& p, long gtid, long gsz) {
    ITEMS((long)NB * NCH * 8 * 4096) {
        const int n = (int)(it % 64), pp = (int)((it / 64) % 64), hd = (int)((it / 4096) % 8); const long bc = it / (4096 * 8); const int g = hd / 4;
        const float alast = p.acs[(bc * CH + CH - 1) * 8 + hd]; float acc = 0.f;
        for (int l = 0; l < CH; ++l) { const long t = bc * CH + l; const act_t* r = p.xbc + (size_t)t * XBC;
            acc += a2f(r[512 + g * 64 + n]) * expf(alast - p.acs[t * 8 + hd]) * (a2f(r[hd * 64 + pp]) * p.dt[t * 8 + hd]); }
        p.st_ssd[it] = acc;
    }
}
DEV void ph_scan(const P& p, long gtid, long gsz) {
    ITEMS((long)NB * 4 * 4096 + (long)NB * 8 * 4096) {
        if (it < (long)NB * 4 * 4096) {
            const int el = (int)(it % 4096), h = (int)((it / 4096) % 4), b = (int)(it / (4096 * 4));
            const float dec = expf(loggamma(h) * (float)CH); float S = 0.f;
            for (int c = 0; c < NCH; ++c) { float* q = p.st_ret + (((size_t)b * NCH + c) * 4 + h) * 4096 + el; const float v = *q; *q = S; S = dec * S + v; }
        } else {
            const long i2 = it - (long)NB * 4 * 4096; const int el = (int)(i2 % 4096), hd = (int)((i2 / 4096) % 8), b = (int)(i2 / (4096 * 8));
            float S = 0.f;
            for (int c = 0; c < NCH; ++c) { float* q = p.st_ssd + (((size_t)b * NCH + c) * 8 + hd) * 4096 + el; const float v = *q; *q = S; S = p.cdec[((size_t)b * NCH + c) * 8 + hd] * S + v; }
        }
    }
}
DEV void ph_ret_o(const P& p, long gtid, long gsz) {
    ITEMS((long)T * 256) {
        const int e = (int)(it % 64), h = (int)((it / 64) % 4); const long t = it / 256; const int i = (int)(t % CH); const long bc = t / CH;
        const float lg = loggamma(h); const act_t* qi = p.u + (size_t)t * UN + U_RQ + h * 64;
        float acc = 0.f;
        for (int j = 0; j <= i; ++j) { const act_t* r = p.u + (size_t)(bc * CH + j) * UN; float s = 0.f;
            for (int d = 0; d < 64; ++d) s += a2f(qi[d]) * a2f(r[U_RK + h * 64 + d]);
            acc += s * expf(lg * (float)(i - j)) * a2f(r[U_RV + h * 64 + e]); }
        const float* pv = p.st_ret + ((size_t)bc * 4 + h) * 4096; float cr = 0.f;
        for (int d = 0; d < 64; ++d) cr += a2f(qi[d]) * pv[d * 64 + e];
        p.ymix[(size_t)t * D + h * 64 + e] = f2a(acc + expf(lg * (float)(i + 1)) * cr);
    }
}
DEV void ph_ret_norm(const P& p, long gtid, long gsz) {
    ITEMS((long)T * 4) {
        const int h = (int)(it % 4); const long t = it / 4; act_t* o = p.ymix + (size_t)t * D + h * 64;
        float mu = 0.f; for (int e = 0; e < 64; ++e) mu += a2f(o[e]); mu *= (1.0f / 64.0f);
        float var = 0.f; for (int e = 0; e < 64; ++e) { const float dlt = a2f(o[e]) - mu; var += dlt * dlt; } var *= (1.0f / 64.0f);
        const float rs = 1.0f / sqrtf(var + LN_EPS);
        for (int e = 0; e < 64; ++e) { const float g = a2f(p.u[(size_t)t * UN + U_RG + h * 64 + e]); o[e] = f2a(siluf(g) * ((a2f(o[e]) - mu) * rs)); }
    }
}
DEV void ph_ssd_y(const P& p, int layer, long gtid, long gsz) {
    ITEMS((long)T * 512) {
        const int pp = (int)(it % 64), hd = (int)((it / 64) % 8); const long t = it / 512; const int l = (int)(t % CH); const long bc = t / CH; const int g = hd / 4;
        const act_t* rl = p.xbc + (size_t)t * XBC; const float al = p.acs[t * 8 + hd];
        float acc = 0.f;
        for (int s = 0; s <= l; ++s) { const long ts = bc * CH + s; const act_t* rs = p.xbc + (size_t)ts * XBC; float cb = 0.f;
            for (int n = 0; n < 64; ++n) cb += a2f(rl[640 + g * 64 + n]) * a2f(rs[512 + g * 64 + n]);
            acc += cb * expf(al - p.acs[ts * 8 + hd]) * (a2f(rs[hd * 64 + pp]) * p.dt[ts * 8 + hd]); }
        const float* pv = p.st_ssd + ((size_t)bc * 8 + hd) * 4096 + pp * 64; float off = 0.f;
        for (int n = 0; n < 64; ++n) off += a2f(rl[640 + g * 64 + n]) * pv[n];
        p.ymix[(size_t)t * D + 256 + hd * 64 + pp] = f2a(acc + off * expf(al) + a2f(rl[hd * 64 + pp]) * p.d_skip[layer * 8 + hd]);
    }
}
DEV void ph_ssd_norm(const P& p, int layer, long gtid, long gsz) {
    ITEMS((long)T * 2) {
        const int g = (int)(it % 2); const long t = it / 2;
        float ms = 0.f;
        for (int k = 0; k < 256; ++k) { const int ch = g * 256 + k; const float hv = a2f(p.ymix[(size_t)t * D + 256 + ch]) * siluf(a2f(p.u[(size_t)t * UN + U_SZ + ch])); ms += hv * hv; }
        const float rs = 1.0f / sqrtf(ms * (1.0f / 256.0f) + LN_EPS);
        for (int k = 0; k < 256; ++k) { const int ch = g * 256 + k; const float hv = a2f(p.ymix[(size_t)t * D + 256 + ch]) * siluf(a2f(p.u[(size_t)t * UN + U_SZ + ch]));
            p.ymix[(size_t)t * D + 256 + ch] = f2a(hv * rs * p.ssd_norm_w[layer * 512 + ch]); }
    }
}
DEV void ph_swa(const P& p, int layer, long gtid, long gsz) {
    ITEMS((long)T * 256) {
        const int d = (int)(it % 64), hq = (int)((it / 64) % 4); const long t = it / 256; const int l = (int)(t % L); const int kvh = hq / 2;
        const act_t* q = p.u + (size_t)t * UN + U_AQ + hq * 64;
        float m = p.sinks[layer * 4 + hq], den = 1.0f, acc = 0.f;
        const int j0 = l - 127 > 0 ? l - 127 : 0;
        for (int j = j0; j <= l; ++j) { const act_t* r = p.u + (size_t)(t - l + j) * UN; float s = 0.f;
            for (int dd = 0; dd < 64; ++dd) s += a2f(q[dd]) * a2f(r[U_AK + kvh * 64 + dd]);
            s = s * 0.125f + p.rel_bias[T5B[l - j] * 4 + hq];
            if (s > m) { const float sc = expf(m - s); den *= sc; acc *= sc; m = s; }
            const float pr = expf(s - m); den += pr; acc += pr * a2f(r[U_AV + kvh * 64 + d]); }
        p.ymix[(size_t)t * D + 768 + hq * 64 + d] = f2a(acc / den);
    }
}
DEV int moe_rb(const P& p, int e) { int acc = 0; for (int k = 0; k < NE; ++k) if (k < e) acc += (p.cnt[k] + 255) / 256 * 256; return acc; }
DEV float ln_fval(const P& p, int fsrc, long t, int d, size_t r0, size_t r1) {
    if (fsrc == 0) return p.gout[t * D + d];
    return p.top_w[t * 2] * a2f(p.ybuf[r0 * D + d]) + p.top_w[t * 2 + 1] * a2f(p.ybuf[r1 * D + d]);
}
DEV void ph_ln(const P& p, int layer, int which, const float* xin, float* xout, int fsrc, int hl, int hsel, long gtid, long gsz) {
    ITEMS(T) {
        const long t = it; const int b = (int)(t / L);
        size_t r0 = 0, r1 = 0; if (fsrc == 1) { r0 = (size_t)moe_rb(p, p.top_e[t * 2]) + p.top_p[t * 2]; r1 = (size_t)moe_rb(p, p.top_e[t * 2 + 1]) + p.top_p[t * 2 + 1]; }
        const float* gate = p.mod + ((size_t)layer * NB + b) * 6 * D + (which ? 5 : 2) * D;
        float mu = 0.f; for (int d = 0; d < D; ++d) mu += ALPHA * xin[t * D + d] + (1.0f + gate[d]) * ln_fval(p, fsrc, t, d, r0, r1); mu *= (1.0f / D);
        float var = 0.f; for (int d = 0; d < D; ++d) { const float v = ALPHA * xin[t * D + d] + (1.0f + gate[d]) * ln_fval(p, fsrc, t, d, r0, r1) - mu; var += v * v; } var *= (1.0f / D);
        const float rs = 1.0f / sqrtf(var + LN_EPS);
        const float* lg = p.ln_g + ((size_t)layer * 2 + which) * D; const float* lb = p.ln_b + ((size_t)layer * 2 + which) * D;
        const float* m = hl >= 0 ? p.mod + ((size_t)hl * NB + b) * 6 * D + hsel * 3 * D : nullptr;
        for (int d = 0; d < D; ++d) { const float v = ALPHA * xin[t * D + d] + (1.0f + gate[d]) * ln_fval(p, fsrc, t, d, r0, r1);
            const float o = (v - mu) * rs * lg[d] + lb[d]; xout[t * D + d] = o;
            if (m) p.hb[t * D + d] = f2a(o * (1.0f + m[D + d]) + m[d]); }
    }
}
DEV void ph_route(const P& p, int layer, const float* xin, long gtid, long gsz) {
    ITEMS(T) {
        const long t = it; const int b = (int)(t / L);
        const float* m = p.mod + ((size_t)layer * NB + b) * 6 * D + 3 * D;
        float lg0 = 0, lg1 = 0, lg2 = 0, lg3 = 0, lg4 = 0, lg5 = 0, lg6 = 0, lg7 = 0;
        for (int d = 0; d < D; ++d) { const float hv = xin[t * D + d] * (1.0f + m[D + d]) + m[d]; const float* w = p.router_w + (size_t)d * NE;
            lg0 += hv * w[0]; lg1 += hv * w[1]; lg2 += hv * w[2]; lg3 += hv * w[3]; lg4 += hv * w[4]; lg5 += hv * w[5]; lg6 += hv * w[6]; lg7 += hv * w[7]; }
        float v1 = -3.0e38f, v2 = -3.0e38f; int i1 = 0, i2 = 0;
#define RT_STEP(e, val) { const float vv = (val) + p.router_b[e]; if (vv > v1) { v2 = v1; i2 = i1; v1 = vv; i1 = e; } else if (vv > v2) { v2 = vv; i2 = e; } }
        RT_STEP(0, lg0) RT_STEP(1, lg1) RT_STEP(2, lg2) RT_STEP(3, lg3) RT_STEP(4, lg4) RT_STEP(5, lg5) RT_STEP(6, lg6) RT_STEP(7, lg7)
#undef RT_STEP
        const float w1 = 1.0f / (1.0f + expf(v2 - v1));
        const int p1 = atomic_inc(p.cnt + i1), p2 = atomic_inc(p.cnt + i2);
        p.slot_tok[(size_t)i1 * T + p1] = (int)t; p.slot_tok[(size_t)i2 * T + p2] = (int)t;
        p.top_e[t * 2] = i1; p.top_e[t * 2 + 1] = i2; p.top_p[t * 2] = p1; p.top_p[t * 2 + 1] = p2; p.top_w[t * 2] = w1; p.top_w[t * 2 + 1] = 1.0f - w1;
    }
}

struct GG { const act_t* A; int lda; const int* gather; int M; const float* B; const float* B2; int ldb; int skip_at, skip_by; int K; void* C; int ldc; int mode; };
#ifdef CPU_EMU
static void gg_tile(const GG& g, int mt, int nt) {
    for (int r = 0; r < 128; ++r) { const int m = mt * 128 + r; if (m >= g.M) break; const int ar = g.gather ? g.gather[m] : m;
        for (int cc = 0; cc < 64; ++cc) { const int n = nt * 64 + cc, bc = n >= g.skip_at ? n + g.skip_by : n; float a1 = 0.f, a2 = 0.f;
            for (int k = 0; k < g.K; ++k) { const float av = g.A[(size_t)ar * g.lda + k]; a1 += av * g.B[(size_t)k * g.ldb + bc]; if (g.mode == 2) a2 += av * g.B2[(size_t)k * g.ldb + bc]; }
            if (g.mode == 0) ((float*)g.C)[(size_t)m * g.ldc + n] = a1; else ((act_t*)g.C)[(size_t)m * g.ldc + n] = f2a(g.mode == 2 ? siluf(a1) * a2 : a1); } }
}
#else
__device__ __forceinline__ void gg_tile(const GG& g, int mt, int nt, float* sm) {
    float* As = sm; float* Bs = sm + 16 * 132; float* B2s = Bs + 16 * 64;
    const int tid = threadIdx.x, ty = tid >> 4, tx = tid & 15;
    float a1[4][4], a2[4][4];
#pragma unroll
    for (int i = 0; i < 4; ++i)
#pragma unroll
        for (int j = 0; j < 4; ++j) { a1[i][j] = 0.f; a2[i][j] = 0.f; }
    const int ar_ = tid >> 2, ak_ = (tid & 3) * 4; const int am = mt * 128 + ar_; const bool aval = am < g.M;
    const int arow = aval ? (g.gather ? g.gather[am] : am) : 0;
    const act_t* Ap = g.A + (size_t)arow * g.lda + ak_;
    const int bk_ = tid >> 5, bn_ = (tid & 31) * 2; const int n0 = nt * 64 + bn_;
    const int bc0 = n0 >= g.skip_at ? n0 + g.skip_by : n0, bc1 = (n0 + 1) >= g.skip_at ? n0 + 1 + g.skip_by : n0 + 1;
    for (int k0 = 0; k0 < g.K; k0 += 16) {
#pragma unroll
        for (int i = 0; i < 4; ++i) As[(ak_ + i) * 132 + ar_] = aval ? a2f(Ap[k0 + i]) : 0.f;
        const float* bp = g.B + (size_t)(k0 + bk_) * g.ldb; Bs[bk_ * 64 + bn_] = bp[bc0]; Bs[bk_ * 64 + bn_ + 1] = bp[bc1];
        if (g.mode == 2) { const float* bp2 = g.B2 + (size_t)(k0 + bk_) * g.ldb; B2s[bk_ * 64 + bn_] = bp2[bc0]; B2s[bk_ * 64 + bn_ + 1] = bp2[bc1]; }
        __syncthreads();
#pragma unroll
        for (int k = 0; k < 16; ++k) {
            float av[4], bv[4], cv[4];
#pragma unroll
            for (int i = 0; i < 4; ++i) { av[i] = As[k * 132 + ty * 4 + i]; bv[i] = Bs[k * 64 + tx * 4 + i]; cv[i] = g.mode == 2 ? B2s[k * 64 + tx * 4 + i] : 0.f; }
#pragma unroll
            for (int i = 0; i < 4; ++i)
#pragma unroll
                for (int j = 0; j < 4; ++j) { a1[i][j] += av[i] * bv[j]; if (g.mode == 2) a2[i][j] += av[i] * cv[j]; }
        }
        __syncthreads();
    }
#pragma unroll
    for (int i = 0; i < 4; ++i) { const int m = mt * 128 + ty * 4 + i; if (m < g.M) {
#pragma unroll
        for (int j = 0; j < 4; ++j) { const int n = nt * 64 + tx * 4 + j;
            if (g.mode == 0) ((float*)g.C)[(size_t)m * g.ldc + n] = a1[i][j]; else ((act_t*)g.C)[(size_t)m * g.ldc + n] = f2a(g.mode == 2 ? siluf(a1[i][j]) * a2[i][j] : a1[i][j]); } } }
}
#endif

#ifdef CPU_EMU
#define GG_TILE(g, mt, nt) gg_tile(g, mt, nt)
#define SM_ARG
#define SM_PARM
#else
#define GG_TILE(g, mt, nt) gg_tile(g, mt, nt, sm)
#define SM_ARG , sm
#define SM_PARM , float* sm
#endif
DEV void ph_gemm_plain(const GG& g, int N, int bid, int nblk SM_PARM) {
    const int ntn = N / 64, ntm = (g.M + 127) / 128;
    for (int tIdx = bid; tIdx < ntn * ntm; tIdx += nblk) GG_TILE(g, tIdx / ntn, tIdx % ntn);
}
DEV void ph_gemm_moe(const P& p, int which, int pass, int bid, int nblk SM_PARM) {
    const int N = which ? D : DFFE, ntn = N / 64, ntm = T / 128;
    for (long tIdx = bid; tIdx < (long)NE * ntm * ntn; tIdx += nblk) {
        const int nt = (int)(tIdx % ntn), mt = (int)((tIdx / ntn) % ntm), e = (int)(tIdx / ((long)ntn * ntm));
        if (mt * 128 >= p.cnt[e]) continue;
        const int rbe = moe_rb(p, e); const ptrdiff_t arow0 = (ptrdiff_t)rbe - (ptrdiff_t)pass * CAPR;
        const int grow = rbe + mt * 128;
        if (grow < pass * CAPR || grow >= (pass + 1) * CAPR) continue;
        GG g;
        if (which == 0) { g.A = p.hb; g.lda = D; g.gather = p.slot_tok + (size_t)e * T; g.M = p.cnt[e]; g.B = p.ex_wg + (size_t)e * D * DFFE; g.B2 = p.ex_wu + (size_t)e * D * DFFE; g.ldb = DFFE;
            g.skip_at = 1 << 30; g.skip_by = 0; g.K = D; g.C = p.act + arow0 * DFFE; g.ldc = DFFE; g.mode = 2; }
        else { g.A = p.act + arow0 * DFFE; g.lda = DFFE; g.gather = nullptr; g.M = p.cnt[e]; g.B = p.ex_wd + (size_t)e * DFFE * D; g.B2 = nullptr; g.ldb = D;
            g.skip_at = 1 << 30; g.skip_by = 0; g.K = DFFE; g.C = p.ybuf + (size_t)rbe * D; g.ldc = D; g.mode = 1; }
        GG_TILE(g, mt, nt);
    }
}

constexpr size_t al256(size_t v) { return (v + 255) & ~(size_t)255; }
struct WsMap {
    size_t mod, cs, hb, u, dtraw, dt, acs, xbc, st_ret, st_ssd, cdec, ymix, gout, xb, act, ybuf, cnt, slot_tok, top_e, top_p, top_w, win_t, wout_t, wgu_t, wd_t, egu_t, ed_t, end;
};
static WsMap make_map() {
    WsMap m; size_t o = 0;
    const size_t A = sizeof(act_t);
    m.cnt = o; o += CTL_BYTES;
    m.mod = o; o += al256((size_t)2 * NB * 6 * D * 4);
    m.cs = o; o += al256((size_t)T * 64 * 4);
    m.hb = o; o += al256((size_t)T * D * A);
    m.dtraw = o; o += al256((size_t)T * 8 * 4);
    m.dt = o; o += al256((size_t)T * 8 * 4);
    m.acs = o; o += al256((size_t)T * 8 * 4);
    m.cdec = o; o += al256((size_t)NB * NCH * 8 * 4);
    m.xb = o; o += al256((size_t)T * D * 4);
    m.slot_tok = o; o += al256((size_t)NE * T * 4);
    m.top_e = o; o += al256((size_t)T * 2 * 4);
    m.top_p = o; o += al256((size_t)T * 2 * 4);
    m.top_w = o; o += al256((size_t)T * 2 * 4);
    m.win_t = o; o += al256((size_t)2 * UNP * D * A);
    m.wout_t = o; o += al256((size_t)2 * D * D * A);
    m.wgu_t = o; o += al256((size_t)2 * DFF * D * A);
    m.wd_t = o; o += al256((size_t)D * DFF * A);
    m.egu_t = o; o += al256((size_t)NE * 2 * DFFE * D * A);
    m.ed_t = o; o += al256((size_t)NE * D * DFFE * A);
    const size_t r1 = o; size_t r1e = r1;
    m.u = r1; m.ymix = r1 + al256((size_t)T * UN * A); r1e = m.ymix + al256((size_t)T * D * A);
    m.act = r1; { size_t e1 = r1 + al256((size_t)T * DFF * A); if (e1 > r1e) r1e = e1; size_t e2 = r1 + al256((size_t)CAPR * DFFE * A); if (e2 > r1e) r1e = e2; }
    o = r1e;
    const size_t r2 = o; size_t q = r2;
    m.xbc = q; q += al256((size_t)T * XBC * A);
    m.st_ret = q; q += al256((size_t)NB * NCH * 4 * 4096 * 4);
    m.st_ssd = q; q += al256((size_t)NB * NCH * 8 * 4096 * 4);
    m.gout = r2; { size_t e = r2 + al256((size_t)T * D * 4); if (e > q) q = e; }
    m.ybuf = r2; { size_t e = r2 + al256((size_t)MAXROWS * D * A); if (e > q) q = e; }
    o = q;
    m.end = o;
    return m;
}

static void fill_params(P& p, void* const* d_in, void* d_out, void* d_ws, const WsMap& m) {
    p.x = (const float*)d_in[0]; p.c = (const float*)d_in[1]; p.pos = (const int*)d_in[2]; p.rel_bias = (const float*)d_in[3]; p.w_ada = (const float*)d_in[4]; p.b_ada = (const float*)d_in[5];
    p.w_in = (const float*)d_in[6]; p.w_out = (const float*)d_in[7]; p.conv_w = (const float*)d_in[8]; p.conv_b = (const float*)d_in[9]; p.dt_bias = (const float*)d_in[10]; p.a_log = (const float*)d_in[11];
    p.d_skip = (const float*)d_in[12]; p.ssd_norm_w = (const float*)d_in[13]; p.sinks = (const float*)d_in[14]; p.ln_g = (const float*)d_in[15]; p.ln_b = (const float*)d_in[16];
    p.ffn_wg = (const float*)d_in[17]; p.ffn_wu = (const float*)d_in[18]; p.ffn_wd = (const float*)d_in[19]; p.router_w = (const float*)d_in[20]; p.router_b = (const float*)d_in[21];
    p.ex_wg = (const float*)d_in[22]; p.ex_wu = (const float*)d_in[23]; p.ex_wd = (const float*)d_in[24];
    p.out = (float*)d_out;
    char* w = (char*)d_ws;
    p.mod = (float*)(w + m.mod); p.cs = (float*)(w + m.cs); p.hb = (act_t*)(w + m.hb); p.u = (act_t*)(w + m.u); p.dtraw = (float*)(w + m.dtraw); p.dt = (float*)(w + m.dt); p.acs = (float*)(w + m.acs);
    p.xbc = (act_t*)(w + m.xbc); p.st_ret = (float*)(w + m.st_ret); p.st_ssd = (float*)(w + m.st_ssd); p.cdec = (float*)(w + m.cdec);
    p.ymix = (act_t*)(w + m.ymix); p.gout = (float*)(w + m.gout); p.xb = (float*)(w + m.xb); p.act = (act_t*)(w + m.act); p.ybuf = (act_t*)(w + m.ybuf);
    p.win_t = (act_t*)(w + m.win_t); p.wout_t = (act_t*)(w + m.wout_t); p.wgu_t = (act_t*)(w + m.wgu_t); p.wd_t = (act_t*)(w + m.wd_t); p.egu_t = (act_t*)(w + m.egu_t); p.ed_t = (act_t*)(w + m.ed_t);
    p.cnt = (int*)(w + m.cnt); p.bar = (unsigned*)(w + m.cnt + CTL_BAR_OFF); p.slot_tok = (int*)(w + m.slot_tok); p.top_e = (int*)(w + m.top_e); p.top_p = (int*)(w + m.top_p); p.top_w = (float*)(w + m.top_w);
}

enum { PH_MOD = 0, PH_ROTAB, PH_MODUL0, PH_DTRAW, PH_INPROJ, PH_ROTARY, PH_CONV, PH_DT, PH_RSTATE, PH_SSTATE, PH_SCAN, PH_RETO, PH_RETN, PH_SSDY, PH_SSDN, PH_SWA, PH_OUTPROJ, PH_LN1,
       PH_FFN_GU, PH_FFN_DN, PH_LN2, PH_ROUTE, PH_MOE_GU0, PH_MOE_DN0, PH_MOE_GU1, PH_MOE_DN1, PH_LN2M };

template <int ph> DEV void run_phase(const P& p, int layer, long gtid, long gsz, int bid, int nblk SM_PARM) {
    const float* xin = layer == 0 ? p.x : p.xb;
    float* x1 = p.out;
    if constexpr (ph == PH_MOD) ph_mod(p, gtid, gsz);
    if constexpr (ph == PH_ROTAB) ph_rotab(p, gtid, gsz);
    if constexpr (ph == PH_MODUL0) ph_modulate(p, 0, p.x, 0, gtid, gsz);
    if constexpr (ph == PH_DTRAW) ph_dtraw(p, layer, xin, gtid, gsz);
    if constexpr (ph == PH_INPROJ) { GG g; g.A = p.hb; g.lda = D; g.gather = nullptr; g.M = T; g.B = p.w_in + (size_t)layer * D * IN_DIM; g.B2 = nullptr; g.ldb = IN_DIM; g.skip_at = W_DT; g.skip_by = 8; g.K = D; g.C = p.u; g.ldc = UN; g.mode = 1;
        ph_gemm_plain(g, UN, bid, nblk SM_ARG); }
    if constexpr (ph == PH_ROTARY) ph_rotary(p, gtid, gsz);
    if constexpr (ph == PH_CONV) ph_conv(p, layer, gtid, gsz);
    if constexpr (ph == PH_DT) ph_dt(p, layer, gtid, gsz);
    if constexpr (ph == PH_RSTATE) ph_ret_state(p, gtid, gsz);
    if constexpr (ph == PH_SSTATE) ph_ssd_state(p, gtid, gsz);
    if constexpr (ph == PH_SCAN) ph_scan(p, gtid, gsz);
    if constexpr (ph == PH_RETO) ph_ret_o(p, gtid, gsz);
    if constexpr (ph == PH_RETN) ph_ret_norm(p, gtid, gsz);
    if constexpr (ph == PH_SSDY) ph_ssd_y(p, layer, gtid, gsz);
    if constexpr (ph == PH_SSDN) ph_ssd_norm(p, layer, gtid, gsz);
    if constexpr (ph == PH_SWA) ph_swa(p, layer, gtid, gsz);
    if constexpr (ph == PH_OUTPROJ) { GG g; g.A = p.ymix; g.lda = D; g.gather = nullptr; g.M = T; g.B = p.w_out + (size_t)layer * D * D; g.B2 = nullptr; g.ldb = D; g.skip_at = 1 << 30; g.skip_by = 0; g.K = D; g.C = p.gout; g.ldc = D; g.mode = 0;
        ph_gemm_plain(g, D, bid, nblk SM_ARG); }
    if constexpr (ph == PH_LN1) ph_ln(p, layer, 0, xin, x1, 0, layer, 1, gtid, gsz);
    if constexpr (ph == PH_FFN_GU) { GG g; g.A = p.hb; g.lda = D; g.gather = nullptr; g.M = T; g.B = p.ffn_wg; g.B2 = p.ffn_wu; g.ldb = DFF; g.skip_at = 1 << 30; g.skip_by = 0; g.K = D; g.C = p.act; g.ldc = DFF; g.mode = 2;
        ph_gemm_plain(g, DFF, bid, nblk SM_ARG); }
    if constexpr (ph == PH_FFN_DN) { GG g; g.A = p.act; g.lda = DFF; g.gather = nullptr; g.M = T; g.B = p.ffn_wd; g.B2 = nullptr; g.ldb = D; g.skip_at = 1 << 30; g.skip_by = 0; g.K = DFF; g.C = p.gout; g.ldc = D; g.mode = 0;
        ph_gemm_plain(g, D, bid, nblk SM_ARG); }
    if constexpr (ph == PH_LN2) ph_ln(p, layer, 1, x1, p.xb, 0, 1, 0, gtid, gsz);
    if constexpr (ph == PH_ROUTE) ph_route(p, layer, x1, gtid, gsz);
    if constexpr (ph == PH_MOE_GU0) ph_gemm_moe(p, 0, 0, bid, nblk SM_ARG);
    if constexpr (ph == PH_MOE_DN0) ph_gemm_moe(p, 1, 0, bid, nblk SM_ARG);
    if constexpr (ph == PH_MOE_GU1) ph_gemm_moe(p, 0, 1, bid, nblk SM_ARG);
    if constexpr (ph == PH_MOE_DN1) ph_gemm_moe(p, 1, 1, bid, nblk SM_ARG);
    if constexpr (ph == PH_LN2M) ph_ln(p, layer, 1, x1, p.out, 1, -1, 0, gtid, gsz);
}

static const int PROGRAM[][2] = {
    {PH_MOD, 0}, {PH_ROTAB, 0}, {PH_MODUL0, 0},
    {PH_DTRAW, 0}, {PH_INPROJ, 0}, {PH_ROTARY, 0}, {PH_CONV, 0}, {PH_DT, 0}, {PH_RSTATE, 0}, {PH_SSTATE, 0}, {PH_SCAN, 0}, {PH_RETO, 0}, {PH_RETN, 0}, {PH_SSDY, 0}, {PH_SSDN, 0}, {PH_SWA, 0},
    {PH_OUTPROJ, 0}, {PH_LN1, 0}, {PH_FFN_GU, 0}, {PH_FFN_DN, 0}, {PH_LN2, 0},
    {PH_DTRAW, 1}, {PH_INPROJ, 1}, {PH_ROTARY, 1}, {PH_CONV, 1}, {PH_DT, 1}, {PH_RSTATE, 1}, {PH_SSTATE, 1}, {PH_SCAN, 1}, {PH_RETO, 1}, {PH_RETN, 1}, {PH_SSDY, 1}, {PH_SSDN, 1}, {PH_SWA, 1},
    {PH_OUTPROJ, 1}, {PH_LN1, 1}, {PH_ROUTE, 1}, {PH_MOE_GU0, 1}, {PH_MOE_DN0, 1}, {PH_MOE_GU1, 1}, {PH_MOE_DN1, 1}, {PH_LN2M, 1},
};
constexpr int NPROG = sizeof(PROGRAM) / sizeof(PROGRAM[0]);

#ifndef CPU_EMU
#define XB_TMO      128
#define XB_XCNT(j)  (256  + 64 * (j))
#define XB_XSUB(j)  (1280 + 64 * (j))
#define XB_XGEN(j)  (2304 + 64 * (j))
#define XB_TOP      3328
#define XB_TOPGEN   3392
#define XCD_BAR_WORDS 3456
#define XB_SPIN_CAP (1u << 18)
#define LAS __attribute__((address_space(3)))

__device__ __forceinline__ unsigned xb_ld(unsigned* p)              { return __hip_atomic_load(p, __ATOMIC_RELAXED, __HIP_MEMORY_SCOPE_AGENT); }
__device__ __forceinline__ unsigned xb_add(unsigned* p, unsigned v) { return __hip_atomic_fetch_add(p, v, __ATOMIC_RELAXED, __HIP_MEMORY_SCOPE_AGENT); }
__device__ __forceinline__ unsigned xb_xcc_id() { return (unsigned)__builtin_amdgcn_s_getreg((3 << 11) | 20) & 0xFu; }
#define XB_SPIN(cond, bar) do { unsigned _sp = 0; while (cond) { __builtin_amdgcn_s_sleep(1); \
    if ((++_sp & 255u) == 0u) { if (xb_ld(&(bar)[XB_TMO])) break; if (_sp > XB_SPIN_CAP) { atomicAdd(&(bar)[XB_TMO], 1u); break; } } } } while (0)

struct XcdBarrier {
    unsigned* bar; unsigned x;
    volatile LAS unsigned* st;
};
__device__ __forceinline__ XcdBarrier xcd_barrier_post(unsigned* bar, volatile LAS unsigned* st) {
    XcdBarrier b; b.bar = bar; b.x = xb_xcc_id(); b.st = st;
    if (threadIdx.x == 0) (void)xb_add(&bar[XB_XCNT(b.x)], 1u);
    return b;
}
__device__ __forceinline__ void xcd_barrier_complete(unsigned* bar, unsigned x, unsigned& nloc, unsigned& nx) {
    const unsigned G = gridDim.x * gridDim.y * gridDim.z;
    unsigned sum, cnt, mine, sp = 0u;
    for (;;) {
        sum = 0u; cnt = 0u; mine = 0u;
#pragma unroll
        for (unsigned j = 0; j < 16; ++j) { const unsigned c = xb_ld(&bar[XB_XCNT(j)]); sum += c; cnt += (c > 0u) ? 1u : 0u; mine = (j == x) ? c : mine; }
        if (sum == G) break;
        __builtin_amdgcn_s_sleep(1);
        if ((++sp & 255u) == 0u) { if (xb_ld(&bar[XB_TMO])) break; if (sp > XB_SPIN_CAP) { atomicAdd(&bar[XB_TMO], 1u); break; } }
    }
    nloc = mine > 0u ? mine : 1u; nx = cnt > 0u ? cnt : 1u;
}
__device__ __forceinline__ void xcd_barrier(const XcdBarrier& b) {
    asm volatile("s_waitcnt vmcnt(0)" ::: "memory");
    __syncthreads();
    if (threadIdx.x == 0) {
        unsigned* bar = b.bar;
        __builtin_amdgcn_s_waitcnt(0);
        unsigned nloc = b.st[0], nx = b.st[1];
        if (nloc == 0u) { xcd_barrier_complete(bar, b.x, nloc, nx); b.st[0] = nloc; b.st[1] = nx; }
        const unsigned old = xb_add(&bar[XB_XSUB(b.x)], 1u);
        const unsigned gen = old / nloc;
        if (old + 1u == (gen + 1u) * nloc) {
            __builtin_amdgcn_fence(__ATOMIC_RELEASE, "agent");
            asm volatile("s_waitcnt vmcnt(0)" ::: "memory");
            const unsigned og = xb_add(&bar[XB_TOP], 1u);
            const unsigned tg = og / nx;
            if (og + 1u == (tg + 1u) * nx) xb_add(&bar[XB_TOPGEN], 1u);
            else XB_SPIN(xb_ld(&bar[XB_TOPGEN]) == tg, bar);
            __builtin_amdgcn_fence(__ATOMIC_ACQUIRE, "agent");
            xb_add(&bar[XB_XGEN(b.x)], 1u);
            asm volatile("s_waitcnt vmcnt(0)" ::: "memory");
        } else {
            XB_SPIN(xb_ld(&bar[XB_XGEN(b.x)]) == gen, bar);
            __builtin_amdgcn_fence(__ATOMIC_ACQUIRE, "agent");
            asm volatile("s_waitcnt vmcnt(0)" ::: "memory");
        }
    }
    __syncthreads();
}

__device__ __forceinline__ int ltid() { int t = threadIdx.x; asm volatile("" : "+v"(t)); return t; }

namespace pg8 {
#define PG8_LAS __attribute__((address_space(3)))
typedef unsigned short bf16_t;
typedef short bf16x8 __attribute__((ext_vector_type(8)));
typedef float f32x4 __attribute__((ext_vector_type(4)));
typedef unsigned u32x4 __attribute__((ext_vector_type(4)));
constexpr int BM = 256, BK = 64, HALF = 128, HTB = HALF * BK * 2  , STAGE_BYTES = 8 * HTB, NXCD = 8, WGM = 8;

__host__ __device__ __forceinline__ int lds_byte(int r, int c) { const int st = (r >> 4) * 2 + (c >> 5), rr = r & 15, cc = c & 31, ob = rr * 64 + cc * 2; return st * 1024 + (ob ^ (((ob >> 9) & 1) << 5)); }
__host__ __device__ __forceinline__ void stage_rc(int b, int& R, int& C) { const int st = b / 1024, sb = b % 1024, swz = sb ^ (((sb >> 9) & 1) << 5); R = (st >> 1) * 16 + swz / 64; C = (st & 1) * 32 + (swz % 64) / 2; }
__host__ __device__ __forceinline__ int perm32(int rho) { const int n = rho >> 4, i = rho & 15; return 8 * (i >> 2) + 4 * n + (i & 3); }

struct Unit { int pm, pn, am, e, rt; };

__device__ __forceinline__ bool static_deal(int i, int G, int c, int nM, int nN, int& pm, int& pn) {
    const int nwg = nM * nN; const long Lx = (long)i * G + c; if (Lx >= nwg) return false;
    int wgid = (int)Lx; { const int q = nwg / NXCD, r = nwg % NXCD, xcd = wgid % NXCD, off = wgid / NXCD; wgid = (xcd < r ? xcd * (q + 1) : r * (q + 1) + (xcd - r) * q) + off; }
    const int nig = WGM * nN, gid = wgid / nig, fm = gid * WGM, gsz = (nM - fm) < WGM ? (nM - fm) : WGM;
    pm = fm + ((wgid % nig) % gsz); pn = (wgid % nig) / gsz; return true;
}
struct StaticOrder {
    const char* A; const char* Bt; size_t tstepA, tstepB; int nM, nN, G, c;
    __device__ __forceinline__ void init(const bf16_t* A_, const bf16_t* Bt_, int M, int N, int K, int G_, int c_) { A = (const char*)A_; Bt = (const char*)Bt_; tstepA = tstepB = (size_t)BM * K * 2; nM = M / BM; nN = N / BM; G = G_; c = c_; }
    __device__ __forceinline__ bool next(int i, Unit& u) const { int pm, pn; if (!static_deal(i, G, c, nM, nN, pm, pn)) return false; u.pm = pm; u.pn = pn; u.am = pm; u.e = 0; u.rt = pm; return true; }
    __device__ __forceinline__ const char* a_ptr(const Unit& u) const { return A + (size_t)u.am * tstepA; }
    __device__ __forceinline__ const char* b_ptr(const Unit& u) const { return Bt + (size_t)u.pn * tstepB; }
    __device__ __forceinline__ unsigned tok(const Unit&, int) const { return 0u; }
};
struct MoeOrder {
    const PG8_LAS int* tab; const char* A; const char* Bt; const int* slot_tok; size_t tstepA, tstepB, estepB; int nM, nN, G, c, rt0, which;
    __device__ __forceinline__ bool next(int i, Unit& u) const {
        int pm, pn; if (!static_deal(i, G, c, nM, nN, pm, pn)) return false;
        const int rt = rt0 + pm; int e = 0;
#pragma unroll
        for (int k = 1; k < 8; ++k) e += (rt >= tab[k]) ? 1 : 0;
        u.pn = pn; u.am = pm; u.e = e; u.rt = rt; u.pm = which ? rt : pm; return true;
    }
    __device__ __forceinline__ const char* a_ptr(const Unit& u) const { return which ? A + (size_t)u.am * tstepA : A; }
    __device__ __forceinline__ const char* b_ptr(const Unit& u) const { return Bt + (size_t)u.e * estepB + (size_t)u.pn * tstepB; }
    __device__ __forceinline__ unsigned tok(const Unit& u, int row) const {
        const int slot = (u.rt - tab[u.e]) * BM + row; return slot < tab[16 + u.e] ? (unsigned)slot_tok[(size_t)u.e * T + slot] : 0u;
    }
};

__device__ __forceinline__ unsigned cvt_pk_bf16(float lo, float hi) { unsigned r; asm volatile("v_cvt_pk_bf16_f32 %0, %1, %2" : "=v"(r) : "v"(lo), "v"(hi)); return r; }
struct EpiF32 {
    static constexpr bool PERM = false;
    float* C; int ldc;
    __device__ __forceinline__ void operator()(const f32x4 (&acc)[2][2][4][2], const Unit& u, int wr, int wc, int fr, int fq) const {
        const int row0 = u.pm * BM + wr * 64 + fr, col0 = u.pn * BM + wc * 32 + 4 * fq;
#pragma unroll
        for (int ai = 0; ai < 2; ++ai)
#pragma unroll
            for (int m = 0; m < 4; ++m) { float* rowp = C + (size_t)(row0 + ai * HALF + m * 16) * ldc + col0;
#pragma unroll
                for (int bj = 0; bj < 2; ++bj)
#pragma unroll
                    for (int n = 0; n < 2; ++n) *(f32x4*)(rowp + bj * HALF + n * 16) = acc[ai][bj][m][n]; }
    }
};
struct EpiBf16 {
    static constexpr bool PERM = true;
    bf16_t* O; int ldc;
    __device__ __forceinline__ void operator()(const f32x4 (&acc)[2][2][4][2], const Unit& u, int wr, int wc, int fr, int fq) const {
        const int row0 = u.pm * BM + wr * 64 + fr, col0 = u.pn * BM + wc * 32 + 8 * fq;
#pragma unroll
        for (int ai = 0; ai < 2; ++ai)
#pragma unroll
            for (int m = 0; m < 4; ++m) { bf16_t* rowp = O + (size_t)(row0 + ai * HALF + m * 16) * ldc + col0;
#pragma unroll
                for (int bj = 0; bj < 2; ++bj) { const f32x4 v0 = acc[ai][bj][m][0], v1 = acc[ai][bj][m][1];
                    u32x4 w; w.x = cvt_pk_bf16(v0[0], v0[1]); w.y = cvt_pk_bf16(v0[2], v0[3]); w.z = cvt_pk_bf16(v1[0], v1[1]); w.w = cvt_pk_bf16(v1[2], v1[3]);
                    *(u32x4*)(rowp + bj * HALF) = w; } }
    }
};
struct EpiInproj {
    static constexpr bool PERM = true;
    bf16_t* O; float* dtraw;
    __device__ __forceinline__ void operator()(const f32x4 (&acc)[2][2][4][2], const Unit& u, int wr, int wc, int fr, int fq) const {
        if (u.pn < UN / BM) { EpiBf16 e{O, UN}; e(acc, u, wr, wc, fr, fq); }
        else if (wc == 0 && fq == 0) {
#pragma unroll
            for (int ai = 0; ai < 2; ++ai)
#pragma unroll
                for (int m = 0; m < 4; ++m) { float* dp = dtraw + (size_t)(u.pm * BM + wr * 64 + fr + ai * HALF + m * 16) * 8; *(f32x4*)dp = acc[ai][0][m][0]; *(f32x4*)(dp + 4) = acc[ai][0][m][1]; } }
    }
};
__device__ __forceinline__ float silu_fast(float x) { return x * __builtin_amdgcn_rcpf(1.0f + __builtin_amdgcn_exp2f(-1.4426950408889634f * x)); }
struct EpiSwiglu {
    static constexpr bool PERM = true;
    bf16_t* O; int ldc;
    __device__ __forceinline__ void operator()(const f32x4 (&acc)[2][2][4][2], const Unit& u, int wr, int wc, int fr, int fq) const {
        const int row0 = u.pm * BM + wr * 64 + fr, col0 = u.pn * HALF + wc * 32 + 8 * fq;
#pragma unroll
        for (int ai = 0; ai < 2; ++ai)
#pragma unroll
            for (int m = 0; m < 4; ++m) { bf16_t* rowp = O + (size_t)(row0 + ai * HALF + m * 16) * ldc + col0;
                const f32x4 g0 = acc[ai][0][m][0], g1 = acc[ai][0][m][1], u0 = acc[ai][1][m][0], u1 = acc[ai][1][m][1];
                float v[8];
#pragma unroll
                for (int j = 0; j < 4; ++j) { v[j] = silu_fast(g0[j]) * u0[j]; v[4 + j] = silu_fast(g1[j]) * u1[j]; }
                u32x4 w; w.x = cvt_pk_bf16(v[0], v[1]); w.y = cvt_pk_bf16(v[2], v[3]); w.z = cvt_pk_bf16(v[4], v[5]); w.w = cvt_pk_bf16(v[6], v[7]);
                *(u32x4*)rowp = w; }
    }
};

template <class Epi, class Sched, bool ALIGN_EPI, bool GATHER>
__device__ __forceinline__ void gemm_phase(PG8_LAS unsigned char* lds, const int K, const Sched& S, const Epi& E) {
    const int tid = ltid(), wid = __builtin_amdgcn_readfirstlane(tid >> 6), lane = tid & 63, wr = wid >> 2, wc = wid & 3, fr = lane & 15, fq = lane >> 4;
    const int nt = K / BK;
    unsigned voffA[2], voffB[2], cb[2];
#pragma unroll
    for (int i = 0; i < 2; ++i) { int R, C; stage_rc(tid * 16 + i * 8192, R, C); const int Rb = Epi::PERM ? ((R & ~31) + perm32(R & 31)) : R; cb[i] = (unsigned)C * 2u;
        voffA[i] = (unsigned)(R * K + C) * 2u; voffB[i] = (unsigned)(Rb * K + C) * 2u; }
    const size_t kstep = (size_t)(BK * 2);
    const size_t hstep = (size_t)HALF * K * 2;
    const unsigned ldsw = (unsigned)wid * 1024u;
    const int aoff = lds_byte(wr * 64 + fr, fq * 8), boff = lds_byte(wc * 32 + fr, fq * 8);
#define PG8_SA(b, h) (((b) * 2 + (h)) * HTB)
#define PG8_SB(b, h) ((4 + (b) * 2 + (h)) * HTB)
#define PG8_GLDS(src, dstoff) __builtin_amdgcn_global_load_lds((const unsigned*)(src), (PG8_LAS unsigned*)(lds + (dstoff)), 16, 0, 0)
#define PG8_STAGE(bufoff, gbase, voff) do { PG8_GLDS((const char*)(gbase) + (voff)[0], (bufoff) + ldsw); PG8_GLDS((const char*)(gbase) + (voff)[1], (bufoff) + ldsw + 8192); } while (0)
#define PG8_STAGE_A(bufoff, kp, h, nx) do { if constexpr (GATHER) { const unsigned tk_ = (nx) ? gn[h] : gc[h]; const unsigned o0_ = (tk_ & 0xffffu) * (unsigned)(K * 2) + cb[0], o1_ = (tk_ >> 16) * (unsigned)(K * 2) + cb[1]; \
        PG8_GLDS((const char*)(kp) + o0_, (bufoff) + ldsw); PG8_GLDS((const char*)(kp) + o1_, (bufoff) + ldsw + 8192); } \
        else { PG8_STAGE(bufoff, (const char*)(kp) + (h) * hstep, voffA); } } while (0)
#define PG8_LDA(dst, b, h) do { _Pragma("unroll") for (int m = 0; m < 4; ++m) _Pragma("unroll") for (int k = 0; k < 2; ++k) dst[m][k] = *(const PG8_LAS bf16x8*)(lds + PG8_SA(b, h) + aoff + m * 2048 + k * 1024); } while (0)
#define PG8_LDB(dst, b, h) do { _Pragma("unroll") for (int n = 0; n < 2; ++n) _Pragma("unroll") for (int k = 0; k < 2; ++k) dst[n][k] = *(const PG8_LAS bf16x8*)(lds + PG8_SB(b, h) + boff + n * 2048 + k * 1024); } while (0)
#define PG8_MMA(ai, bj, At, Bt) do { __builtin_amdgcn_s_setprio(1); _Pragma("unroll") for (int m = 0; m < 4; ++m) _Pragma("unroll") for (int n = 0; n < 2; ++n) _Pragma("unroll") for (int k = 0; k < 2; ++k) \
        acc[ai][bj][m][n] = __builtin_amdgcn_mfma_f32_16x16x32_bf16(Bt[n][k], At[m][k], acc[ai][bj][m][n], 0, 0, 0); __builtin_amdgcn_s_setprio(0); } while (0)
#define PG8_WAIT_V(n) asm volatile("s_waitcnt vmcnt(" #n ")" ::: "memory")
#define PG8_WAIT_L(n) asm volatile("s_waitcnt lgkmcnt(" #n ")" ::: "memory")
#define PG8_BAR __builtin_amdgcn_s_barrier()
#define PG8_SCHED __builtin_amdgcn_sched_barrier(0)
#define PG8_GOFF(dst, u_) do { int R0_, R1_, C_; stage_rc(tid * 16, R0_, C_); stage_rc(tid * 16 + 8192, R1_, C_); \
        _Pragma("unroll") for (int h_ = 0; h_ < 2; ++h_) dst[h_] = S.tok(u_, h_ * HALF + R0_) | (S.tok(u_, h_ * HALF + R1_) << 16); \
        asm volatile("" : "+v"(dst[0]), "+v"(dst[1])); } while (0)
    Unit cur, nxt; int ui = 0;
    if (!S.next(0, cur)) return;
    unsigned gc[2] = {0u, 0u}, gn[2] = {0u, 0u};
    if constexpr (GATHER) PG8_GOFF(gc, cur);
    f32x4 acc[2][2][4][2];
#pragma unroll
    for (int a = 0; a < 2; ++a)
#pragma unroll
        for (int b = 0; b < 2; ++b)
#pragma unroll
            for (int m = 0; m < 4; ++m)
#pragma unroll
                for (int n = 0; n < 2; ++n) acc[a][b][m][n] = (f32x4){0.f, 0.f, 0.f, 0.f};
    bf16x8 At[4][2], B0[2][2], B1[2][2];
    const char* cA = S.a_ptr(cur); const char* cB = S.b_ptr(cur);
    PG8_STAGE(PG8_SB(0, 0), cB, voffB); PG8_STAGE(PG8_SB(0, 1), cB + hstep, voffB); PG8_STAGE_A(PG8_SA(0, 0), cA, 0, false); PG8_STAGE_A(PG8_SA(0, 1), cA, 1, false);
    if (wr == 1) PG8_BAR;
    PG8_WAIT_V(2); PG8_BAR;
    PG8_STAGE(PG8_SB(1, 0), cB + kstep, voffB); PG8_STAGE_A(PG8_SA(1, 0), cA + kstep, 0, false); PG8_STAGE(PG8_SB(1, 1), cB + hstep + kstep, voffB);
    PG8_WAIT_V(6); PG8_BAR;
    for (;;) {
        const bool has_next = S.next(ui + 1, nxt);
        if constexpr (GATHER) { if (has_next) PG8_GOFF(gn, nxt); else { gn[0] = gc[0]; gn[1] = gc[1]; } }
        const char* nA = has_next ? S.a_ptr(nxt) : cA; const char* nB = has_next ? S.b_ptr(nxt) : cB;
        for (int t = 0; t < nt; t += 2) {
            const bool last = (t == nt - 2);
            const char* a1 = cA + (size_t)(t + 1) * kstep;
            const char* a2 = last ? nA : cA + (size_t)(t + 2) * kstep; const char* b2 = last ? nB : cB + (size_t)(t + 2) * kstep;
            const char* a3 = a2 + kstep; const char* b3 = b2 + kstep;
            PG8_LDB(B0, 0, 0); PG8_LDB(B1, 0, 1); PG8_SCHED; PG8_LDA(At, 0, 0); PG8_STAGE_A(PG8_SA(1, 1), a1, 1, false);
            PG8_WAIT_V(8); PG8_WAIT_L(0); PG8_BAR; PG8_MMA(0, 0, At, B0); PG8_MMA(0, 1, At, B1); PG8_BAR; PG8_SCHED;
            PG8_LDA(At, 0, 1); PG8_STAGE(PG8_SB(0, 0), b2, voffB); PG8_STAGE(PG8_SB(0, 1), b2 + hstep, voffB); PG8_STAGE_A(PG8_SA(0, 0), a2, 0, last);
            PG8_WAIT_V(8); PG8_WAIT_L(0); PG8_BAR; PG8_MMA(1, 0, At, B0); PG8_MMA(1, 1, At, B1); PG8_BAR; PG8_SCHED;
            PG8_LDB(B0, 1, 0); PG8_LDB(B1, 1, 1); PG8_SCHED; PG8_LDA(At, 1, 0); PG8_STAGE_A(PG8_SA(0, 1), a2, 1, last);
            PG8_WAIT_V(8); PG8_WAIT_L(0); PG8_BAR; PG8_MMA(0, 0, At, B0); PG8_MMA(0, 1, At, B1); PG8_BAR; PG8_SCHED;
            PG8_LDA(At, 1, 1); PG8_STAGE(PG8_SB(1, 0), b3, voffB); PG8_STAGE(PG8_SB(1, 1), b3 + hstep, voffB); PG8_STAGE_A(PG8_SA(1, 0), a3, 0, last);
            PG8_WAIT_V(8); PG8_WAIT_L(0); PG8_BAR; PG8_MMA(1, 0, At, B0); PG8_MMA(1, 1, At, B1); PG8_BAR; PG8_SCHED;
        }
        if constexpr (ALIGN_EPI) { if (wr == 0) PG8_BAR; }
        E(acc, cur, wr, wc, fr, fq);
        if (!has_next) break;
#pragma unroll
        for (int a = 0; a < 2; ++a)
#pragma unroll
            for (int b = 0; b < 2; ++b)
#pragma unroll
                for (int m = 0; m < 4; ++m)
#pragma unroll
                    for (int n = 0; n < 2; ++n) acc[a][b][m][n] = (f32x4){0.f, 0.f, 0.f, 0.f};
        cur = nxt; cA = nA; cB = nB; ++ui;
        if constexpr (GATHER) { gc[0] = gn[0]; gc[1] = gn[1]; }
        if constexpr (ALIGN_EPI) { if (wr == 1) PG8_BAR; }
    }
    PG8_WAIT_V(0);
    if constexpr (!ALIGN_EPI) { if (wr == 0) PG8_BAR; }
    PG8_BAR;
#undef PG8_SA
#undef PG8_SB
#undef PG8_GLDS
#undef PG8_STAGE
#undef PG8_STAGE_A
#undef PG8_LDA
#undef PG8_LDB
#undef PG8_MMA
#undef PG8_WAIT_V
#undef PG8_WAIT_L
#undef PG8_BAR
#undef PG8_SCHED
#undef PG8_GOFF
}
}

constexpr int LDS_BYTES = 147456, LDS_CTL_OFF = 131072, LDS_BAR_OFF = LDS_CTL_OFF + 64, LDS_MOE_OFF = LDS_CTL_OFF + 256;
typedef unsigned v4u __attribute__((ext_vector_type(4)));
#define LDS_WAIT() asm volatile("s_waitcnt lgkmcnt(0)" ::: "memory")
__device__ __forceinline__ unsigned pk2(float lo, float hi) { return (unsigned)f2a(lo) | ((unsigned)f2a(hi) << 16); }

__device__ __forceinline__ void wconv_item(const float* W, int ldw, act_t* WT, int K, int k0, int nsrc0, int ndst0, LAS float* scr, int lane, int nvalid = 32) {
#pragma unroll 8
    for (int i = 0; i < 32; ++i) { const int kk = 2 * i + (lane >> 5); scr[kk * 33 + (lane & 31)] = (lane & 31) < nvalid ? W[(size_t)(k0 + kk) * ldw + nsrc0 + (lane & 31)] : 0.f; }
    LDS_WAIT(); asm volatile("" ::: "memory");
    const int c = lane & 7;
#pragma unroll
    for (int j = 0; j < 4; ++j) { const int n = (lane >> 3) + 8 * j; const LAS float* s = scr + (8 * c) * 33 + n;
        v4u o; o.x = pk2(s[0 * 33], s[1 * 33]); o.y = pk2(s[2 * 33], s[3 * 33]); o.z = pk2(s[4 * 33], s[5 * 33]); o.w = pk2(s[6 * 33], s[7 * 33]);
        *(v4u*)(WT + (size_t)(ndst0 + n) * K + k0 + 8 * c) = o; }
    LDS_WAIT(); asm volatile("" ::: "memory");
}
__device__ __forceinline__ int gu_row(int c, int up) { return (c >> 7) * 256 + (c & 127) + up * 128; }

__device__ __forceinline__ void ph_wconv(const P& p, int sel, unsigned char* lds, int gw, int ngw, int lane, int wave) {
    LAS float* scr = (LAS float*)lds + wave * (64 * 33 + 64);
    if (sel == 0) {
        constexpr int I_IN = 16 * (UNP / 32), I_OUT = 16 * 32, I_G = 16 * (DFF / 32), I_D = (DFF / 64) * 32;
        constexpr int NIT = 2 * I_IN + 2 * I_OUT + 2 * I_G + I_D;
        for (int it = gw; it < NIT; it += ngw) {
            int r = it;
            if (r < 2 * I_IN) { const int l = r / I_IN; r %= I_IN; const int kb = r / (UNP / 32), nb = r % (UNP / 32), nd = nb * 32, ns = nd < W_DT ? nd : (nd < UN ? nd + 8 : W_DT);
                wconv_item(p.w_in + (size_t)l * D * IN_DIM, IN_DIM, p.win_t + (size_t)l * UNP * D, D, kb * 64, ns, nd, scr, lane, nd < UN ? 32 : (nd == UN ? 8 : 0)); continue; } r -= 2 * I_IN;
            if (r < 2 * I_OUT) { const int l = r / I_OUT; r %= I_OUT; const int kb = r / 32, nb = r % 32;
                wconv_item(p.w_out + (size_t)l * D * D, D, p.wout_t + (size_t)l * D * D, D, kb * 64, nb * 32, nb * 32, scr, lane); continue; } r -= 2 * I_OUT;
            if (r < 2 * I_G) { const int up = r / I_G; r %= I_G; const int kb = r / (DFF / 32), nb = r % (DFF / 32);
                wconv_item(up ? p.ffn_wu : p.ffn_wg, DFF, p.wgu_t, D, kb * 64, nb * 32, gu_row(nb * 32, up), scr, lane); continue; } r -= 2 * I_G;
            { const int kb = r / 32, nb = r % 32; wconv_item(p.ffn_wd, D, p.wd_t, DFF, kb * 64, nb * 32, nb * 32, scr, lane); }
        }
    } else {
        constexpr int I_G = 16 * (DFFE / 32), I_D = (DFFE / 64) * 32;
        constexpr int NIT = NE * (2 * I_G + I_D);
        for (int it = gw; it < NIT; it += ngw) {
            const int e = it / (2 * I_G + I_D); int r = it % (2 * I_G + I_D);
            if (r < 2 * I_G) { const int up = r / I_G; r %= I_G; const int kb = r / (DFFE / 32), nb = r % (DFFE / 32);
                wconv_item((up ? p.ex_wu : p.ex_wg) + (size_t)e * D * DFFE, DFFE, p.egu_t + (size_t)e * 2 * DFFE * D, D, kb * 64, nb * 32, gu_row(nb * 32, up), scr, lane); continue; } r -= 2 * I_G;
            { const int kb = r / 32, nb = r % 32; wconv_item(p.ex_wd + (size_t)e * DFFE * D, D, p.ed_t + (size_t)e * D * DFFE, DFFE, kb * 64, nb * 32, nb * 32, scr, lane); }
        }
    }
}

typedef float f32x4 __attribute__((ext_vector_type(4)));
typedef unsigned u32x2 __attribute__((ext_vector_type(2)));
__device__ __forceinline__ float wave_sum(float v) {
#pragma unroll
    for (int o = 1; o < 64; o <<= 1) v += __shfl_xor(v, o);
    return v;
}
__device__ __forceinline__ void fp_mod(const P& p, unsigned char* lds) {
    LAS float* red = (LAS float*)lds;
    const int tid = ltid(), wave_ = tid >> 6, lane_ = tid & 63, kq = lane_ >> 4, c4 = (lane_ & 15) * 4;
    for (int item = blockIdx.x; item < 2 * 96; item += gridDim.x) {
        const int l = item / 96, n0 = (item % 96) * 64;
        const float* w = p.w_ada + (size_t)l * D * 6 * D + n0 + c4;
        f32x4 a0 = {0.f, 0.f, 0.f, 0.f}, a1 = {0.f, 0.f, 0.f, 0.f};
#pragma unroll 8
        for (int i = 0; i < 32; ++i) { const int k = wave_ * 128 + i * 4 + kq; const f32x4 wv = *(const f32x4*)(w + (size_t)k * 6 * D); const float c0 = p.c[k], c1 = p.c[D + k]; a0 += wv * c0; a1 += wv * c1; }
#pragma unroll
        for (int j = 0; j < 4; ++j) { a0[j] += __shfl_xor(a0[j], 16); a0[j] += __shfl_xor(a0[j], 32); a1[j] += __shfl_xor(a1[j], 16); a1[j] += __shfl_xor(a1[j], 32); }
        if (kq == 0) { *(LAS f32x4*)(red + (wave_ * 2 + 0) * 64 + c4) = a0; *(LAS f32x4*)(red + (wave_ * 2 + 1) * 64 + c4) = a1; }
        __syncthreads();
        if (tid < 128) { const int b = tid >> 6, cc = tid & 63; float s = 0.f;
#pragma unroll
            for (int w8 = 0; w8 < 8; ++w8) s += red[(w8 * 2 + b) * 64 + cc];
            p.mod[((size_t)l * NB + b) * 6 * D + n0 + cc] = s + p.b_ada[l * 6 * D + n0 + cc]; }
        __syncthreads();
    }
}
__device__ __forceinline__ void fp_modulate0(const P& p) {
    const size_t n4 = (size_t)T * D / 4;
    for (size_t i = (size_t)blockIdx.x * 512 + ltid(); i < n4; i += (size_t)gridDim.x * 512) {
        const size_t t = i / (D / 4); const int d = (int)(i % (D / 4)) * 4, b = (int)(t / L);
        const float* m = p.mod + (size_t)b * 6 * D;
        const f32x4 xv = *(const f32x4*)(p.x + i * 4), sh = *(const f32x4*)(m + d), sc = *(const f32x4*)(m + D + d);
        const f32x4 h = xv * (sc + 1.0f) + sh;
        u32x2 o; o.x = pk2(h[0], h[1]); o.y = pk2(h[2], h[3]); *(u32x2*)(p.hb + i * 4) = o;
    }
}
__device__ __forceinline__ void fp_scan(const P& p) {
    constexpr int NR = NB * 4 * 4096, NS = NB * 8 * 4096;
    for (int it = blockIdx.x * 512 + ltid(); it < NR + NS; it += gridDim.x * 512) {
        float* base; size_t stride; const float* cd = nullptr; float dec = 0.f;
        if (it < NR) { const int el = it % 4096, h = (it / 4096) % 4, b = it / (4096 * 4); base = p.st_ret + ((size_t)b * NCH * 4 + h) * 4096 + el; stride = (size_t)4 * 4096; dec = expf(loggamma(h) * (float)CH); }
        else { const int i2 = it - NR; const int el = i2 % 4096, hd = (i2 / 4096) % 8, b = i2 / (4096 * 8); base = p.st_ssd + ((size_t)b * NCH * 8 + hd) * 4096 + el; stride = (size_t)8 * 4096; cd = p.cdec + (size_t)b * NCH * 8 + hd; }
        float S = 0.f;
        for (int c0 = 0; c0 < NCH; c0 += 8) {
            float v[8], dd[8];
#pragma unroll
            for (int j = 0; j < 8; ++j) { v[j] = base[(size_t)(c0 + j) * stride]; dd[j] = cd ? cd[(size_t)(c0 + j) * 8] : dec; }
#pragma unroll
            for (int j = 0; j < 8; ++j) { base[(size_t)(c0 + j) * stride] = S; S = dd[j] * S + v[j]; }
        }
    }
}
template <int FSRC, bool HNEXT, bool ROUTE>
__device__ __forceinline__ void fp_ln(const P& p, int layer, int which, const float* xin, float* xout, int hl, int hsel, unsigned char* lds) {
    const int tid = ltid(), wave_ = __builtin_amdgcn_readfirstlane(tid >> 6), lane_ = tid & 63;
    LAS float* rw = (LAS float*)lds;
    if constexpr (ROUTE) { for (int i = tid; i < D * NE / 4; i += 512) *(LAS f32x4*)(rw + i * 4) = *(const f32x4*)(p.router_w + i * 4); __syncthreads(); }
    const float* lg = p.ln_g + ((size_t)layer * 2 + which) * D; const float* lb = p.ln_b + ((size_t)layer * 2 + which) * D;
    for (int row = blockIdx.x * 8 + wave_; row < T; row += gridDim.x * 8) {
        const int b = row / L;
        const float* gate = p.mod + ((size_t)layer * NB + b) * 6 * D + (which ? 5 : 2) * D;
        f32x4 v[4]; float s = 0.f;
        float w0 = 0.f, w1 = 0.f; size_t r0 = 0, r1 = 0;
        if constexpr (FSRC == 1) { const int e0 = p.top_e[row * 2], e1 = p.top_e[row * 2 + 1]; r0 = (size_t)moe_rb(p, e0) + p.top_p[row * 2]; r1 = (size_t)moe_rb(p, e1) + p.top_p[row * 2 + 1]; w0 = p.top_w[row * 2]; w1 = p.top_w[row * 2 + 1]; }
#pragma unroll
        for (int j = 0; j < 4; ++j) { const int idx = 4 * lane_ + 256 * j; const f32x4 xv = *(const f32x4*)(xin + (size_t)row * D + idx), gt = *(const f32x4*)(gate + idx); f32x4 fv;
            if constexpr (FSRC == 0) fv = *(const f32x4*)(p.gout + (size_t)row * D + idx);
            else { const u32x2 ya = *(const u32x2*)(p.ybuf + r0 * D + idx), yb = *(const u32x2*)(p.ybuf + r1 * D + idx);
                fv[0] = w0 * __uint_as_float(ya.x << 16) + w1 * __uint_as_float(yb.x << 16); fv[1] = w0 * __uint_as_float(ya.x & 0xffff0000u) + w1 * __uint_as_float(yb.x & 0xffff0000u);
                fv[2] = w0 * __uint_as_float(ya.y << 16) + w1 * __uint_as_float(yb.y << 16); fv[3] = w0 * __uint_as_float(ya.y & 0xffff0000u) + w1 * __uint_as_float(yb.y & 0xffff0000u); }
            v[j] = xv * ALPHA + (gt + 1.0f) * fv; s += (v[j][0] + v[j][1]) + (v[j][2] + v[j][3]); }
        const float mean = wave_sum(s) * (1.0f / D); float s2 = 0.f;
#pragma unroll
        for (int j = 0; j < 4; ++j) { v[j] = v[j] - mean; s2 += (v[j][0] * v[j][0] + v[j][1] * v[j][1]) + (v[j][2] * v[j][2] + v[j][3] * v[j][3]); }
        const float rs = 1.0f / sqrtf(wave_sum(s2) * (1.0f / D) + LN_EPS);
        const float* m = p.mod + ((size_t)(hl < 0 ? 0 : hl) * NB + b) * 6 * D + hsel * 3 * D;
        float lgt[NE];
#pragma unroll
        for (int e = 0; e < NE; ++e) lgt[e] = 0.f;
#pragma unroll
        for (int j = 0; j < 4; ++j) { const int idx = 4 * lane_ + 256 * j; const f32x4 o = v[j] * rs * *(const f32x4*)(lg + idx) + *(const f32x4*)(lb + idx);
            *(f32x4*)(xout + (size_t)row * D + idx) = o;
            if constexpr (HNEXT || ROUTE) { const f32x4 h = o * (*(const f32x4*)(m + D + idx) + 1.0f) + *(const f32x4*)(m + idx);
                if constexpr (HNEXT) { u32x2 hv; hv.x = pk2(h[0], h[1]); hv.y = pk2(h[2], h[3]); *(u32x2*)(p.hb + (size_t)row * D + idx) = hv; }
                if constexpr (ROUTE) {
#pragma unroll
                    for (int cc = 0; cc < 4; ++cc) { const f32x4 wa = *(const LAS f32x4*)(rw + (idx + cc) * 8), wb = *(const LAS f32x4*)(rw + (idx + cc) * 8 + 4);
                        lgt[0] += h[cc] * wa[0]; lgt[1] += h[cc] * wa[1]; lgt[2] += h[cc] * wa[2]; lgt[3] += h[cc] * wa[3]; lgt[4] += h[cc] * wb[0]; lgt[5] += h[cc] * wb[1]; lgt[6] += h[cc] * wb[2]; lgt[7] += h[cc] * wb[3]; } } } }
        if constexpr (ROUTE) {
#pragma unroll
            for (int e = 0; e < NE; ++e) lgt[e] = wave_sum(lgt[e]) + p.router_b[e];
            float v1 = -3.0e38f, v2 = -3.0e38f; int i1 = 0, i2 = 0;
#pragma unroll
            for (int e = 0; e < NE; ++e) { const float vv = lgt[e]; if (vv > v1) { v2 = v1; i2 = i1; v1 = vv; i1 = e; } else if (vv > v2) { v2 = vv; i2 = e; } }
            if (lane_ == 0) { const float wt1 = 1.0f / (1.0f + expf(v2 - v1));
                const int p1 = atomicAdd(p.cnt + i1, 1), p2 = atomicAdd(p.cnt + i2, 1);
                p.slot_tok[(size_t)i1 * T + p1] = row; p.slot_tok[(size_t)i2 * T + p2] = row;
                p.top_e[row * 2] = i1; p.top_e[row * 2 + 1] = i2; p.top_p[row * 2] = p1; p.top_p[row * 2 + 1] = p2; p.top_w[row * 2] = wt1; p.top_w[row * 2 + 1] = 1.0f - wt1; }
        }
    }
    if constexpr (ROUTE) __syncthreads();
}

typedef short mbf16x8 __attribute__((ext_vector_type(8)));
typedef unsigned mu32x4 __attribute__((ext_vector_type(4)));
__device__ __forceinline__ mbf16x8 ldfrag(const LAS act_t* base, int ld, int row, int k) { return *(const LAS mbf16x8*)(base + row * ld + k); }
#define MFMA16(a, b, c) __builtin_amdgcn_mfma_f32_16x16x32_bf16(a, b, c, 0, 0, 0)
__device__ __forceinline__ float bf_lo(unsigned w) { return __uint_as_float(w << 16); }
__device__ __forceinline__ float bf_hi(unsigned w) { return __uint_as_float(w & 0xffff0000u); }
__device__ __forceinline__ void unpack8(const mu32x4 w, float* f) { f[0] = bf_lo(w.x); f[1] = bf_hi(w.x); f[2] = bf_lo(w.y); f[3] = bf_hi(w.y); f[4] = bf_lo(w.z); f[5] = bf_hi(w.z); f[6] = bf_lo(w.w); f[7] = bf_hi(w.w); }
__device__ __forceinline__ mu32x4 pack8(const float* f) { mu32x4 w; w.x = pk2(f[0], f[1]); w.y = pk2(f[2], f[3]); w.z = pk2(f[4], f[5]); w.w = pk2(f[6], f[7]); return w; }
__device__ __forceinline__ float fsilu(float x) { return x / (1.0f + __expf(-x)); }
constexpr float LOG2E = 1.4426950408889634f;

__device__ __forceinline__ void mx_ret_state(const P& p, int bc, int h, unsigned char* lds) {
    LAS act_t* kT = (LAS act_t*)lds; LAS act_t* vT = kT + 64 * 136;
    const int tid = ltid(), lane_ = tid & 63, w = __builtin_amdgcn_readfirstlane(tid >> 6), fr = lane_ & 15, fq = lane_ >> 4;
    const size_t t0 = (size_t)bc * CH; const float l2g = loggamma(h) * LOG2E;
    { const int row = tid >> 2, c8 = (tid & 3) * 8; const size_t t = t0 + row;
      act_t* qp = p.u + t * UN + U_RQ + h * 64; act_t* kp = p.u + t * UN + U_RK + h * 64; const float* csr = p.cs + t * 64;
      float cs_[8], sn_[8]; *(f32x4*)cs_ = *(const f32x4*)(csr + c8); *(f32x4*)(cs_ + 4) = *(const f32x4*)(csr + c8 + 4); *(f32x4*)sn_ = *(const f32x4*)(csr + 32 + c8); *(f32x4*)(sn_ + 4) = *(const f32x4*)(csr + 36 + c8);
      float a[8], b[8], n1[8], n2[8];
      unpack8(*(const mu32x4*)(qp + c8), a); unpack8(*(const mu32x4*)(qp + 32 + c8), b);
#pragma unroll
      for (int x = 0; x < 8; ++x) { n1[x] = a[x] * cs_[x] - b[x] * sn_[x]; n2[x] = a[x] * sn_[x] + b[x] * cs_[x]; }
      *(mu32x4*)(qp + c8) = pack8(n1); *(mu32x4*)(qp + 32 + c8) = pack8(n2);
      unpack8(*(const mu32x4*)(kp + c8), a); unpack8(*(const mu32x4*)(kp + 32 + c8), b);
#pragma unroll
      for (int x = 0; x < 8; ++x) { n1[x] = (a[x] * cs_[x] - b[x] * sn_[x]) * 0.125f; n2[x] = (a[x] * sn_[x] + b[x] * cs_[x]) * 0.125f; }
      *(mu32x4*)(kp + c8) = pack8(n1); *(mu32x4*)(kp + 32 + c8) = pack8(n2);
      const float dk = __builtin_amdgcn_exp2f(l2g * (float)(CH - 1 - row));
#pragma unroll
      for (int x = 0; x < 8; ++x) { kT[(c8 + x) * 136 + row] = f2a(n1[x] * dk); kT[(32 + c8 + x) * 136 + row] = f2a(n2[x] * dk); }
    }
#pragma unroll
    for (int i = 0; i < 2; ++i) { const int id = tid + 512 * i, row = id >> 3, c8 = (id & 7) * 8; const mu32x4 vv = *(const mu32x4*)(p.u + (t0 + row) * UN + U_RV + h * 64 + c8);
        vT[(c8 + 0) * 136 + row] = (act_t)(vv.x & 0xffffu); vT[(c8 + 1) * 136 + row] = (act_t)(vv.x >> 16); vT[(c8 + 2) * 136 + row] = (act_t)(vv.y & 0xffffu); vT[(c8 + 3) * 136 + row] = (act_t)(vv.y >> 16);
        vT[(c8 + 4) * 136 + row] = (act_t)(vv.z & 0xffffu); vT[(c8 + 5) * 136 + row] = (act_t)(vv.z >> 16); vT[(c8 + 6) * 136 + row] = (act_t)(vv.w & 0xffffu); vT[(c8 + 7) * 136 + row] = (act_t)(vv.w >> 16); }
    __syncthreads();
    const int eb = w & 3, db0 = (w >> 2) * 2;
    f32x4 acc[2] = {{0.f, 0.f, 0.f, 0.f}, {0.f, 0.f, 0.f, 0.f}};
#pragma unroll
    for (int ks = 0; ks < 4; ++ks) { const mbf16x8 sv = ldfrag(vT, 136, 16 * eb + fr, 32 * ks + 8 * fq);
#pragma unroll
        for (int d2 = 0; d2 < 2; ++d2) acc[d2] = MFMA16(ldfrag(kT, 136, 16 * (db0 + d2) + fr, 32 * ks + 8 * fq), sv, acc[d2]); }
    float* st = p.st_ret + ((size_t)bc * 4 + h) * 4096;
#pragma unroll
    for (int d2 = 0; d2 < 2; ++d2) *(f32x4*)(st + (16 * eb + fr) * 64 + 16 * (db0 + d2) + 4 * fq) = acc[d2];
    __syncthreads();
}

__device__ __forceinline__ void mx_ssd_state(const P& p, int layer, int bc, int g, unsigned char* lds) {
    LAS act_t* xsT = (LAS act_t*)lds;
    LAS act_t* BT = xsT + 4 * 64 * 136;
    LAS float* dtw = (LAS float*)(BT + 64 * 136);
    const int tid = ltid(), lane_ = tid & 63, w = __builtin_amdgcn_readfirstlane(tid >> 6), fr = lane_ & 15, fq = lane_ >> 4;
    const size_t t0 = (size_t)bc * CH; const int n = bc % NCH;
    if (w < 4) {
        const int hd = 4 * g + w; const float bias = p.dt_bias[layer * 8 + hd], A = -expf(p.a_log[layer * 8 + hd]);
        const size_t ta = t0 + 2 * lane_;
        const float d0 = softplusf(p.dtraw[ta * 8 + hd] + bias), d1 = softplusf(p.dtraw[(ta + 1) * 8 + hd] + bias);
        const float a0 = A * d0, a1 = A * d1; float inc = a0 + a1;
#pragma unroll
        for (int o = 1; o < 64; o <<= 1) { const float v = __shfl_up(inc, o); if (lane_ >= o) inc += v; }
        const float alast = __shfl(inc, 63), c1 = inc, c0 = inc - a1;
        p.dt[ta * 8 + hd] = d0; p.dt[(ta + 1) * 8 + hd] = d1; p.acs[ta * 8 + hd] = c0; p.acs[(ta + 1) * 8 + hd] = c1;
        dtw[w * 128 + 2 * lane_] = d0 * expf(alast - c0); dtw[w * 128 + 2 * lane_ + 1] = d1 * expf(alast - c1);
        if (lane_ == 0) p.cdec[(size_t)bc * 8 + hd] = expf(alast);
    }
    __syncthreads();
    if (tid < 384) {
        const int cg = tid % 48, rs = tid / 48, l0 = rs * 16;
        const int xc = cg < 32 ? 256 * g + cg * 8 : (cg < 40 ? 512 + 64 * g + (cg - 32) * 8 : 640 + 64 * g + (cg - 40) * 8);
        float cw[4][8], cbias[8];
#pragma unroll
        for (int k = 0; k < 4; ++k) { *(f32x4*)cw[k] = *(const f32x4*)(p.conv_w + ((size_t)layer * 4 + k) * XBC + xc); *(f32x4*)(cw[k] + 4) = *(const f32x4*)(p.conv_w + ((size_t)layer * 4 + k) * XBC + xc + 4); }
        *(f32x4*)cbias = *(const f32x4*)(p.conv_b + layer * XBC + xc); *(f32x4*)(cbias + 4) = *(const f32x4*)(p.conv_b + layer * XBC + xc + 4);
        float x0[8], x1[8], x2[8], x3[8];
        const act_t* src = p.u + t0 * UN + U_XS + xc;
        const bool first = (n == 0 && rs == 0);
        if (first) {
#pragma unroll
            for (int x = 0; x < 8; ++x) { x0[x] = 0.f; x1[x] = 0.f; x2[x] = 0.f; } }
        else { unpack8(*(const mu32x4*)(src + (ptrdiff_t)(l0 - 3) * UN), x0); unpack8(*(const mu32x4*)(src + (ptrdiff_t)(l0 - 2) * UN), x1); unpack8(*(const mu32x4*)(src + (ptrdiff_t)(l0 - 1) * UN), x2); }
#pragma unroll 4
        for (int r = 0; r < 16; ++r) { const int l = l0 + r;
            unpack8(*(const mu32x4*)(src + (size_t)l * UN), x3);
            float y[8];
#pragma unroll
            for (int x = 0; x < 8; ++x) { const float a = cbias[x] + x0[x] * cw[0][x] + x1[x] * cw[1][x] + x2[x] * cw[2][x] + x3[x] * cw[3][x]; y[x] = fsilu(a); x0[x] = x1[x]; x1[x] = x2[x]; x2[x] = x3[x]; }
            *(mu32x4*)(p.xbc + (t0 + l) * XBC + xc) = pack8(y);
            if (cg < 32) { const int hh = cg >> 3, p0 = (cg & 7) * 8; const float sc = dtw[hh * 128 + l];
#pragma unroll
                for (int x = 0; x < 8; ++x) xsT[(hh * 64 + p0 + x) * 136 + l] = f2a(y[x] * sc); }
            else if (cg < 40) { const int n0 = (cg - 32) * 8;
#pragma unroll
                for (int x = 0; x < 8; ++x) BT[(n0 + x) * 136 + l] = f2a(y[x]); }
        }
    }
    __syncthreads();
    const int pb = w & 3, nb0 = (w >> 2) * 2;
#pragma unroll
    for (int hh = 0; hh < 4; ++hh) {
        f32x4 acc[2] = {{0.f, 0.f, 0.f, 0.f}, {0.f, 0.f, 0.f, 0.f}};
#pragma unroll
        for (int ks = 0; ks < 4; ++ks) { const mbf16x8 sx = ldfrag(xsT + hh * 64 * 136, 136, 16 * pb + fr, 32 * ks + 8 * fq);
#pragma unroll
            for (int n2 = 0; n2 < 2; ++n2) acc[n2] = MFMA16(ldfrag(BT, 136, 16 * (nb0 + n2) + fr, 32 * ks + 8 * fq), sx, acc[n2]); }
        float* st = p.st_ssd + ((size_t)bc * 8 + 4 * g + hh) * 4096;
#pragma unroll
        for (int n2 = 0; n2 < 2; ++n2) *(f32x4*)(st + (16 * pb + fr) * 64 + 16 * (nb0 + n2) + 4 * fq) = acc[n2];
    }
    __syncthreads();
}

__device__ __forceinline__ void mx_ret_out(const P& p, int bc, int h, unsigned char* lds) {
    LAS act_t* qs = (LAS act_t*)lds;
    LAS act_t* ks_ = qs + 128 * 72;
    LAS act_t* vT = ks_ + 128 * 72;
    LAS act_t* pT = vT + 64 * 136;
    LAS act_t* Pw = pT + 64 * 72;
    const int tid = ltid(), lane_ = tid & 63, w = __builtin_amdgcn_readfirstlane(tid >> 6), fr = lane_ & 15, fq = lane_ >> 4;
    const size_t t0 = (size_t)bc * CH; const float l2g = loggamma(h) * LOG2E;
#pragma unroll
    for (int i = 0; i < 2; ++i) { const int id = tid + 512 * i, row = id >> 3, c8 = (id & 7) * 8; const act_t* ur = p.u + (t0 + row) * UN + h * 64 + c8;
        *(LAS mu32x4*)(qs + row * 72 + c8) = *(const mu32x4*)(ur + U_RQ); *(LAS mu32x4*)(ks_ + row * 72 + c8) = *(const mu32x4*)(ur + U_RK);
        const mu32x4 vv = *(const mu32x4*)(ur + U_RV);
        vT[(c8 + 0) * 136 + row] = (act_t)(vv.x & 0xffffu); vT[(c8 + 1) * 136 + row] = (act_t)(vv.x >> 16); vT[(c8 + 2) * 136 + row] = (act_t)(vv.y & 0xffffu); vT[(c8 + 3) * 136 + row] = (act_t)(vv.y >> 16);
        vT[(c8 + 4) * 136 + row] = (act_t)(vv.z & 0xffffu); vT[(c8 + 5) * 136 + row] = (act_t)(vv.z >> 16); vT[(c8 + 6) * 136 + row] = (act_t)(vv.w & 0xffffu); vT[(c8 + 7) * 136 + row] = (act_t)(vv.w >> 16); }
    { const int e = tid >> 3, d8 = (tid & 7) * 8; const float* sp = p.st_ret + ((size_t)bc * 4 + h) * 4096 + e * 64 + d8; float f[8]; *(f32x4*)f = *(const f32x4*)sp; *(f32x4*)(f + 4) = *(const f32x4*)(sp + 4);
      *(LAS mu32x4*)(pT + e * 72 + d8) = pack8(f); }
    __syncthreads();
    const int i0 = 16 * w, nbmax = w | 1; LAS act_t* Pm = Pw + w * 16 * 136;
    const mbf16x8 q0 = ldfrag(qs, 72, i0 + fr, 8 * fq), q1 = ldfrag(qs, 72, i0 + fr, 32 + 8 * fq);
    for (int nb = 0; nb <= nbmax; ++nb) {
        f32x4 s = {0.f, 0.f, 0.f, 0.f};
        s = MFMA16(ldfrag(ks_, 72, 16 * nb + fr, 8 * fq), q0, s); s = MFMA16(ldfrag(ks_, 72, 16 * nb + fr, 32 + 8 * fq), q1, s);
        const int i = i0 + fr, j0 = 16 * nb + 4 * fq; float pv[4];
#pragma unroll
        for (int r = 0; r < 4; ++r) { const int j = j0 + r; pv[r] = j <= i ? s[r] * __builtin_amdgcn_exp2f(l2g * (float)(i - j)) : 0.f; }
        u32x2 pk; pk.x = pk2(pv[0], pv[1]); pk.y = pk2(pv[2], pv[3]); *(LAS u32x2*)(Pm + fr * 136 + j0) = pk;
    }
    f32x4 o2[4], o3[4];
#pragma unroll
    for (int eb = 0; eb < 4; ++eb) { o2[eb] = (f32x4){0.f, 0.f, 0.f, 0.f}; o3[eb] = (f32x4){0.f, 0.f, 0.f, 0.f}; }
    const int ksmax = (nbmax + 1) >> 1;
    for (int ks = 0; ks < ksmax; ++ks) { const mbf16x8 pf = ldfrag(Pm, 136, fr, 32 * ks + 8 * fq);
#pragma unroll
        for (int eb = 0; eb < 4; ++eb) o2[eb] = MFMA16(ldfrag(vT, 136, 16 * eb + fr, 32 * ks + 8 * fq), pf, o2[eb]); }
#pragma unroll
    for (int eb = 0; eb < 4; ++eb) { o3[eb] = MFMA16(ldfrag(pT, 72, 16 * eb + fr, 8 * fq), q0, o3[eb]); o3[eb] = MFMA16(ldfrag(pT, 72, 16 * eb + fr, 32 + 8 * fq), q1, o3[eb]); }
    const float dq = __builtin_amdgcn_exp2f(l2g * (float)(i0 + fr + 1)); float sm = 0.f;
#pragma unroll
    for (int eb = 0; eb < 4; ++eb) { o2[eb] = o2[eb] + o3[eb] * dq; sm += (o2[eb][0] + o2[eb][1]) + (o2[eb][2] + o2[eb][3]); }
    sm += __shfl_xor(sm, 16); sm += __shfl_xor(sm, 32); const float mu = sm * (1.0f / 64.0f); float sq = 0.f;
#pragma unroll
    for (int eb = 0; eb < 4; ++eb) { o2[eb] = o2[eb] - mu; sq += (o2[eb][0] * o2[eb][0] + o2[eb][1] * o2[eb][1]) + (o2[eb][2] * o2[eb][2] + o2[eb][3] * o2[eb][3]); }
    sq += __shfl_xor(sq, 16); sq += __shfl_xor(sq, 32); const float rs = 1.0f / sqrtf(sq * (1.0f / 64.0f) + LN_EPS);
    const size_t t = t0 + i0 + fr;
#pragma unroll
    for (int eb = 0; eb < 4; ++eb) { const int e = h * 64 + 16 * eb + 4 * fq; const u32x2 gv = *(const u32x2*)(p.u + t * UN + U_RG + e);
        u32x2 ov; ov.x = pk2(fsilu(bf_lo(gv.x)) * o2[eb][0] * rs, fsilu(bf_hi(gv.x)) * o2[eb][1] * rs); ov.y = pk2(fsilu(bf_lo(gv.y)) * o2[eb][2] * rs, fsilu(bf_hi(gv.y)) * o2[eb][3] * rs);
        *(u32x2*)(p.ymix + t * D + e) = ov; }
    __syncthreads();
}

__device__ __forceinline__ void mx_ssd_out(const P& p, int layer, int bc, int g, unsigned char* lds) {
    LAS act_t* Cm = (LAS act_t*)lds;
    LAS act_t* Bm = Cm + 128 * 72;
    LAS act_t* xsT = Bm + 128 * 72;
    LAS act_t* pv_ = xsT + 64 * 136;
    LAS act_t* Pw = pv_ + 64 * 72;
    LAS float* tab = (LAS float*)(Pw + 8 * 16 * 136);
    const int tid = ltid(), lane_ = tid & 63, w = __builtin_amdgcn_readfirstlane(tid >> 6), fr = lane_ & 15, fq = lane_ >> 4;
    const size_t t0 = (size_t)bc * CH;
#pragma unroll
    for (int i = 0; i < 2; ++i) { const int id = tid + 512 * i, row = id >> 3, c8 = (id & 7) * 8; const act_t* xr = p.xbc + (t0 + row) * XBC + 64 * g + c8;
        *(LAS mu32x4*)(Cm + row * 72 + c8) = *(const mu32x4*)(xr + 640); *(LAS mu32x4*)(Bm + row * 72 + c8) = *(const mu32x4*)(xr + 512); }
    { const int hh = tid >> 7, l = tid & 127; tab[hh * 128 + l] = p.acs[(t0 + l) * 8 + 4 * g + hh]; tab[512 + hh * 128 + l] = p.dt[(t0 + l) * 8 + 4 * g + hh]; }
    __syncthreads();
    const int i0 = 16 * w, nbmax = w | 1, ksmax = (nbmax + 1) >> 1; LAS act_t* Pm = Pw + w * 16 * 136;
    const mbf16x8 c0 = ldfrag(Cm, 72, i0 + fr, 8 * fq), c1 = ldfrag(Cm, 72, i0 + fr, 32 + 8 * fq);
    f32x4 cb[8];
#pragma unroll
    for (int nb = 0; nb < 8; ++nb) { cb[nb] = (f32x4){0.f, 0.f, 0.f, 0.f};
        if (nb <= nbmax) { cb[nb] = MFMA16(ldfrag(Bm, 72, 16 * nb + fr, 8 * fq), c0, cb[nb]); cb[nb] = MFMA16(ldfrag(Bm, 72, 16 * nb + fr, 32 + 8 * fq), c1, cb[nb]); } }
    float ss = 0.f; const size_t t = t0 + i0 + fr;
#pragma unroll
    for (int hh = 0; hh < 4; ++hh) {
        const int hd = 4 * g + hh;
        __syncthreads();
#pragma unroll
        for (int i = 0; i < 2; ++i) { const int id = tid + 512 * i, row = id >> 3, c8 = (id & 7) * 8; const mu32x4 vv = *(const mu32x4*)(p.xbc + (t0 + row) * XBC + hd * 64 + c8);
            xsT[(c8 + 0) * 136 + row] = (act_t)(vv.x & 0xffffu); xsT[(c8 + 1) * 136 + row] = (act_t)(vv.x >> 16); xsT[(c8 + 2) * 136 + row] = (act_t)(vv.y & 0xffffu); xsT[(c8 + 3) * 136 + row] = (act_t)(vv.y >> 16);
            xsT[(c8 + 4) * 136 + row] = (act_t)(vv.z & 0xffffu); xsT[(c8 + 5) * 136 + row] = (act_t)(vv.z >> 16); xsT[(c8 + 6) * 136 + row] = (act_t)(vv.w & 0xffffu); xsT[(c8 + 7) * 136 + row] = (act_t)(vv.w >> 16); }
        { const int pp = tid >> 3, n8 = (tid & 7) * 8; const float* sp = p.st_ssd + ((size_t)bc * 8 + hd) * 4096 + pp * 64 + n8; float f[8]; *(f32x4*)f = *(const f32x4*)sp; *(f32x4*)(f + 4) = *(const f32x4*)(sp + 4);
          *(LAS mu32x4*)(pv_ + pp * 72 + n8) = pack8(f); }
        __syncthreads();
        const float al = tab[hh * 128 + i0 + fr];
#pragma unroll
        for (int nb = 0; nb < 8; ++nb) if (nb <= nbmax) {
            const int i = i0 + fr, j0 = 16 * nb + 4 * fq; const f32x4 as = *(const LAS f32x4*)(tab + hh * 128 + j0), ds = *(const LAS f32x4*)(tab + 512 + hh * 128 + j0); float pvv[4];
#pragma unroll
            for (int r = 0; r < 4; ++r) pvv[r] = (j0 + r) <= i ? cb[nb][r] * __expf(al - as[r]) * ds[r] : 0.f;
            u32x2 pk; pk.x = pk2(pvv[0], pvv[1]); pk.y = pk2(pvv[2], pvv[3]); *(LAS u32x2*)(Pm + fr * 136 + j0) = pk; }
        f32x4 y2[4], y3[4];
#pragma unroll
        for (int pb = 0; pb < 4; ++pb) { y2[pb] = (f32x4){0.f, 0.f, 0.f, 0.f}; y3[pb] = (f32x4){0.f, 0.f, 0.f, 0.f}; }
        for (int ks = 0; ks < ksmax; ++ks) { const mbf16x8 pf = ldfrag(Pm, 136, fr, 32 * ks + 8 * fq);
#pragma unroll
            for (int pb = 0; pb < 4; ++pb) y2[pb] = MFMA16(ldfrag(xsT, 136, 16 * pb + fr, 32 * ks + 8 * fq), pf, y2[pb]); }
#pragma unroll
        for (int pb = 0; pb < 4; ++pb) { y3[pb] = MFMA16(ldfrag(pv_, 72, 16 * pb + fr, 8 * fq), c0, y3[pb]); y3[pb] = MFMA16(ldfrag(pv_, 72, 16 * pb + fr, 32 + 8 * fq), c1, y3[pb]); }
        const float eal = __expf(al), dsk = p.d_skip[layer * 8 + hd];
#pragma unroll
        for (int pb = 0; pb < 4; ++pb) { const int pc = 16 * pb + 4 * fq; const u32x2 zv = *(const u32x2*)(p.u + t * UN + U_SZ + hd * 64 + pc); const u32x2 xv = *(const u32x2*)(p.xbc + t * XBC + hd * 64 + pc);
            f32x4 y = y2[pb] + y3[pb] * eal;
            y[0] = (y[0] + bf_lo(xv.x) * dsk) * fsilu(bf_lo(zv.x)); y[1] = (y[1] + bf_hi(xv.x) * dsk) * fsilu(bf_hi(zv.x)); y[2] = (y[2] + bf_lo(xv.y) * dsk) * fsilu(bf_lo(zv.y)); y[3] = (y[3] + bf_hi(xv.y) * dsk) * fsilu(bf_hi(zv.y));
            ss += (y[0] * y[0] + y[1] * y[1]) + (y[2] * y[2] + y[3] * y[3]);
            u32x2 ov; ov.x = pk2(y[0], y[1]); ov.y = pk2(y[2], y[3]); *(u32x2*)(p.ymix + t * D + 256 + hd * 64 + pc) = ov; }
    }
    ss += __shfl_xor(ss, 16); ss += __shfl_xor(ss, 32); const float rs = 1.0f / sqrtf(ss * (1.0f / 256.0f) + LN_EPS);
#pragma unroll
    for (int hh = 0; hh < 4; ++hh)
#pragma unroll
        for (int pb = 0; pb < 4; ++pb) { const int ch = (4 * g + hh) * 64 + 16 * pb + 4 * fq; const f32x4 nw = *(const f32x4*)(p.ssd_norm_w + layer * 512 + ch);
            const u32x2 yv = *(const u32x2*)(p.ymix + t * D + 256 + ch);
            u32x2 ov; ov.x = pk2(bf_lo(yv.x) * rs * nw[0], bf_hi(yv.x) * rs * nw[1]); ov.y = pk2(bf_lo(yv.y) * rs * nw[2], bf_hi(yv.y) * rs * nw[3]); *(u32x2*)(p.ymix + t * D + 256 + ch) = ov; }
    __syncthreads();
}

__device__ __forceinline__ void mx_swa(const P& p, int layer, int bc, int kvh, unsigned char* lds) {
    LAS act_t* Kw = (LAS act_t*)lds;
    LAS act_t* VT = Kw + 256 * 72;
    LAS act_t* Pw = VT + 64 * 280;
    LAS float* bt = (LAS float*)(Pw + 8 * 16 * 168);
    const int tid = ltid(), lane_ = tid & 63, w = __builtin_amdgcn_readfirstlane(tid >> 6), fr = lane_ & 15, fq = lane_ >> 4;
    const size_t t0 = (size_t)bc * CH; const int nb_ = bc % NCH;
#pragma unroll
    for (int i = 0; i < 4; ++i) { const int id = tid + 512 * i, row = id >> 3, c8 = (id & 7) * 8;
        mu32x4 kk = {0u, 0u, 0u, 0u}, vv = {0u, 0u, 0u, 0u};
        if (nb_ > 0 || row >= 128) { const act_t* ur = p.u + (size_t)((ptrdiff_t)t0 - 128 + row) * UN + kvh * 64 + c8; kk = *(const mu32x4*)(ur + U_AK); vv = *(const mu32x4*)(ur + U_AV); }
        *(LAS mu32x4*)(Kw + row * 72 + c8) = kk;
        VT[(c8 + 0) * 280 + row] = (act_t)(vv.x & 0xffffu); VT[(c8 + 1) * 280 + row] = (act_t)(vv.x >> 16); VT[(c8 + 2) * 280 + row] = (act_t)(vv.y & 0xffffu); VT[(c8 + 3) * 280 + row] = (act_t)(vv.y >> 16);
        VT[(c8 + 4) * 280 + row] = (act_t)(vv.z & 0xffffu); VT[(c8 + 5) * 280 + row] = (act_t)(vv.z >> 16); VT[(c8 + 6) * 280 + row] = (act_t)(vv.w & 0xffffu); VT[(c8 + 7) * 280 + row] = (act_t)(vv.w >> 16); }
    for (int i = tid; i < 64 * 24; i += 512) VT[(i / 24) * 280 + 256 + (i % 24)] = (act_t)0;
    if (tid < 256) { const int hq2 = tid >> 7, dist = tid & 127; bt[tid] = p.rel_bias[T5B[dist] * 4 + 2 * kvh + hq2]; }
    __syncthreads();
    const int i0 = 16 * w; LAS act_t* Pm = Pw + w * 16 * 168;
    const size_t t = t0 + i0 + fr;
#pragma unroll 1
    for (int hq2 = 0; hq2 < 2; ++hq2) {
        const int hq = 2 * kvh + hq2; const float sink = p.sinks[layer * 4 + hq];
        const act_t* qrow = p.u + t * UN + U_AQ + hq * 64;
        const mbf16x8 q0 = *(const mbf16x8*)(qrow + 8 * fq), q1 = *(const mbf16x8*)(qrow + 32 + 8 * fq);
        f32x4 s[9]; float mx = -3.0e38f;
#pragma unroll
        for (int jb = 0; jb < 9; ++jb) { s[jb] = (f32x4){0.f, 0.f, 0.f, 0.f};
            s[jb] = MFMA16(ldfrag(Kw, 72, 16 * (w + jb) + fr, 8 * fq), q0, s[jb]); s[jb] = MFMA16(ldfrag(Kw, 72, 16 * (w + jb) + fr, 32 + 8 * fq), q1, s[jb]);
#pragma unroll
            for (int r = 0; r < 4; ++r) { const int jw = 16 * (w + jb) + 4 * fq + r, dist = 128 + i0 + fr - jw; const bool ok = dist >= 0 && dist < 128 && (nb_ > 0 || jw >= 128);
                const float lg = ok ? s[jb][r] * 0.125f + bt[hq2 * 128 + (dist & 127)] : -3.0e38f; s[jb][r] = lg; mx = fmaxf(mx, lg); } }
        mx = fmaxf(mx, __shfl_xor(mx, 16)); mx = fmaxf(mx, __shfl_xor(mx, 32)); mx = fmaxf(mx, sink);
        float den = 0.f;
#pragma unroll
        for (int jb = 0; jb < 9; ++jb)
#pragma unroll
            for (int r = 0; r < 4; ++r) { const float pr = s[jb][r] > -1.0e38f ? __expf(s[jb][r] - mx) : 0.f; s[jb][r] = pr; den += pr; }
        den += __shfl_xor(den, 16); den += __shfl_xor(den, 32); den += __expf(sink - mx);
        const float inv = 1.0f / den;
#pragma unroll
        for (int jb = 0; jb < 10; ++jb) { u32x2 pk = {0u, 0u}; if (jb < 9) { pk.x = pk2(s[jb < 9 ? jb : 0][0] * inv, s[jb < 9 ? jb : 0][1] * inv); pk.y = pk2(s[jb < 9 ? jb : 0][2] * inv, s[jb < 9 ? jb : 0][3] * inv); }
            *(LAS u32x2*)(Pm + fr * 168 + 16 * jb + 4 * fq) = pk; }
        f32x4 o[4];
#pragma unroll
        for (int eb = 0; eb < 4; ++eb) o[eb] = (f32x4){0.f, 0.f, 0.f, 0.f};
#pragma unroll
        for (int ks = 0; ks < 5; ++ks) { const mbf16x8 pf = ldfrag(Pm, 168, fr, 32 * ks + 8 * fq);
#pragma unroll
            for (int eb = 0; eb < 4; ++eb) o[eb] = MFMA16(ldfrag(VT, 280, 16 * eb + fr, 16 * w + 32 * ks + 8 * fq), pf, o[eb]); }
#pragma unroll
        for (int eb = 0; eb < 4; ++eb) { u32x2 ov; ov.x = pk2(o[eb][0], o[eb][1]); ov.y = pk2(o[eb][2], o[eb][3]); *(u32x2*)(p.ymix + t * D + 768 + hq * 64 + 16 * eb + 4 * fq) = ov; }
    }
    __syncthreads();
}

__device__ __forceinline__ void fp_mix1(const P& p, int layer, unsigned char* lds) {
    for (int uu = blockIdx.x; uu < 2 * NB * NCH; uu += gridDim.x) { const int bc = uu >> 1, hf = uu & 1;
        mx_ssd_state(p, layer, bc, hf, lds); mx_ret_state(p, bc, 2 * hf, lds); mx_ret_state(p, bc, 2 * hf + 1, lds); }
}
__device__ __forceinline__ void fp_mix3(const P& p, int layer, unsigned char* lds) {
    for (int uu = blockIdx.x; uu < 2 * NB * NCH; uu += gridDim.x) { const int bc = uu >> 1, hf = uu & 1;
        mx_ssd_out(p, layer, bc, hf, lds); mx_swa(p, layer, bc, hf, lds); mx_ret_out(p, bc, 2 * hf, lds); mx_ret_out(p, bc, 2 * hf + 1, lds); }
}

__device__ __forceinline__ void fp_inproj(const P& p, int layer, unsigned char* lds) {
    pg8::StaticOrder S; S.init(p.hb, p.win_t + (size_t)layer * UNP * D, T, UNP, D, gridDim.x, blockIdx.x);
    pg8::EpiInproj E{p.u, p.dtraw};
    pg8::gemm_phase<pg8::EpiInproj, pg8::StaticOrder, true, false>((LAS unsigned char*)lds, D, S, E);
}
__device__ __forceinline__ void fp_outproj(const P& p, int layer, unsigned char* lds) {
    pg8::StaticOrder S; S.init(p.ymix, p.wout_t + (size_t)layer * D * D, T, D, D, gridDim.x, blockIdx.x);
    pg8::EpiF32 E{p.gout, D};
    pg8::gemm_phase<pg8::EpiF32, pg8::StaticOrder, false, false>((LAS unsigned char*)lds, D, S, E);
}
__device__ __forceinline__ void fp_ffn_gu(const P& p, unsigned char* lds) {
    pg8::StaticOrder S; S.init(p.hb, p.wgu_t, T, 2 * DFF, D, gridDim.x, blockIdx.x);
    pg8::EpiSwiglu E{p.act, DFF};
    pg8::gemm_phase<pg8::EpiSwiglu, pg8::StaticOrder, true, false>((LAS unsigned char*)lds, D, S, E);
}
__device__ __forceinline__ void fp_ffn_dn(const P& p, unsigned char* lds) {
    pg8::StaticOrder S; S.init(p.act, p.wd_t, T, D, DFF, gridDim.x, blockIdx.x);
    pg8::EpiF32 E{p.gout, D};
    pg8::gemm_phase<pg8::EpiF32, pg8::StaticOrder, false, false>((LAS unsigned char*)lds, DFF, S, E);
}
__device__ __forceinline__ void moe_table(const P& p, unsigned char* lds) {
    LAS int* tab = (LAS int*)(lds + LDS_MOE_OFF);
    if (ltid() == 0) { int acc = 0;
#pragma unroll
        for (int e = 0; e < NE; ++e) { const int c = p.cnt[e]; tab[e] = acc; tab[16 + e] = c; acc += (c + 255) / 256; }
        tab[8] = acc; }
    __syncthreads();
}
__device__ __forceinline__ void fp_moe(const P& p, int which, int pass, unsigned char* lds) {
    moe_table(p, lds);
    const LAS int* tab = (const LAS int*)(lds + LDS_MOE_OFF);
    int nM = tab[8] - pass * CAPT; nM = nM < 0 ? 0 : (nM > CAPT ? CAPT : nM);
    pg8::MoeOrder S; S.tab = tab; S.slot_tok = p.slot_tok; S.G = gridDim.x; S.c = blockIdx.x; S.rt0 = pass * CAPT; S.which = which; S.nM = nM;
    if (which == 0) { S.A = (const char*)p.hb; S.Bt = (const char*)p.egu_t; S.tstepA = 0; S.tstepB = (size_t)256 * D * 2; S.estepB = (size_t)2 * DFFE * D * 2; S.nN = 2 * DFFE / 256;
        pg8::EpiSwiglu E{p.act, DFFE};
        pg8::gemm_phase<pg8::EpiSwiglu, pg8::MoeOrder, true, true>((LAS unsigned char*)lds, D, S, E);
    } else { S.A = (const char*)p.act; S.Bt = (const char*)p.ed_t; S.tstepA = (size_t)256 * DFFE * 2; S.tstepB = (size_t)256 * DFFE * 2; S.estepB = (size_t)D * DFFE * 2; S.nN = D / 256;
        pg8::EpiBf16 E{p.ybuf, D};
        pg8::gemm_phase<pg8::EpiBf16, pg8::MoeOrder, true, false>((LAS unsigned char*)lds, DFFE, S, E);
    }
}

__global__ void __launch_bounds__(512, 2) mk_fwd(P p) {
    extern __shared__ __attribute__((aligned(16))) unsigned char lds[];
    for (int w = threadIdx.x; w < (LDS_BYTES - LDS_CTL_OFF) / 4; w += 512) ((LAS unsigned*)(lds + LDS_CTL_OFF))[w] = 0u;
    __syncthreads();
    XcdBarrier bar = xcd_barrier_post(p.bar, (volatile LAS unsigned*)(lds + LDS_BAR_OFF));
    float* sm = (float*)lds;
    const int bid = blockIdx.x, nblk = gridDim.x;
#define gtid ((long)(blockIdx.x * 512 + ltid()))
#define gsz ((long)(gridDim.x * 512))
#define PH(id, layer) run_phase<id>(p, layer, gtid, gsz, bid, nblk, sm)
#define BAR() xcd_barrier(bar)
#define lane ((int)(ltid() & 63))
#define wave (__builtin_amdgcn_readfirstlane((int)(ltid() >> 6)))
#define gw ((int)blockIdx.x * 8 + wave)
#define ngw ((int)gridDim.x * 8)
    fp_mod(p, lds); PH(PH_ROTAB, 0); ph_wconv(p, 0, lds, gw, ngw, lane, wave); ph_wconv(p, 1, lds, gw, ngw, lane, wave); BAR();
    fp_modulate0(p); BAR();
#define MIXER(layer) \
        fp_inproj(p, layer, lds); BAR(); \
        fp_mix1(p, layer, lds); BAR(); \
        fp_scan(p); BAR(); \
        fp_mix3(p, layer, lds); BAR(); \
        fp_outproj(p, layer, lds); BAR();
    MIXER(0)
    fp_ln<0, true, false>(p, 0, 0, p.x, p.out, 0, 1, lds); BAR();
    fp_ffn_gu(p, lds); BAR();
    fp_ffn_dn(p, lds); BAR();
    fp_ln<0, true, false>(p, 0, 1, p.out, p.xb, 1, 0, lds); BAR();
    MIXER(1)
    fp_ln<0, true, true>(p, 1, 0, p.xb, p.out, 1, 1, lds); BAR();
    fp_moe(p, 0, 0, lds); BAR();
    fp_moe(p, 1, 0, lds); BAR();
    fp_moe(p, 0, 1, lds); BAR();
    fp_moe(p, 1, 1, lds); BAR();
    fp_ln<1, false, false>(p, 1, 1, p.out, p.out, -1, 0, lds);
#undef MIXER
#undef gtid
#undef gsz
#undef lane
#undef wave
#undef gw
#undef ngw
#undef PH
#undef BAR
}

extern "C" void kernel_launch(void* const* d_in, const int* in_sizes, int n_in, void* d_out, int out_size, void* d_ws, size_t ws_size, hipStream_t stream) {
    static WsMap m = make_map();
    if (n_in != 25 || out_size != T * D || ws_size < m.end) { fprintf(stderr, "kernel_launch: unexpected sizes (n_in %d out %d ws %zu need %zu)\n", n_in, out_size, ws_size, m.end); return; }
    P p; memset(&p, 0, sizeof(p)); fill_params(p, d_in, d_out, d_ws, m);
    (void)hipMemsetAsync((char*)d_ws + m.cnt, 0, CTL_BYTES, stream);
#if 1
    static int grid = 0;
    if (grid == 0) {
        int dev = 0, cus = 0, per_cu = 0;
        if (hipGetDevice(&dev) != hipSuccess || hipDeviceGetAttribute(&cus, hipDeviceAttributeMultiprocessorCount, dev) != hipSuccess) { fprintf(stderr, "kernel_launch: device query failed\n"); grid = -1; return; }
        if (hipFuncSetAttribute((const void*)mk_fwd, hipFuncAttributeMaxDynamicSharedMemorySize, LDS_BYTES) != hipSuccess) { fprintf(stderr, "kernel_launch: hipFuncSetAttribute failed\n"); grid = -1; return; }
        if (hipOccupancyMaxActiveBlocksPerMultiprocessor(&per_cu, (const void*)mk_fwd, 512, LDS_BYTES) != hipSuccess || per_cu < 1) { fprintf(stderr, "kernel_launch: occupancy query says %d blocks per CU\n", per_cu); }
        (void)hipGetLastError();
        grid = cus;
    }
    if (grid < 0) return;
    hipLaunchKernelGGL(mk_fwd, dim3(grid), dim3(512), LDS_BYTES, stream, p);
#endif
}
#endif
```

```cpp
#ifndef CPU_EMU
#include <hip/hip_runtime.h>
#endif
#include <stdint.h>
#include <stdio.h>
#include <math.h>
#include <string.h>
#include <stddef.h>

#ifndef SEQ_
#define SEQ_ 8192
#endif
#ifndef DFF_
#define DFF_ 2816
#endif
#ifndef DFFE_
#define DFFE_ 3584
#endif
#ifndef PROBE_MASK
#define PROBE_MASK 0ull
#endif
constexpr int D = 1024, NB = 2, L = SEQ_, T = NB * L, CH = 128, NCH = L / CH;
constexpr int DFF = DFF_, DFFE = DFFE_, NE = 8;
constexpr int IN_DIM = 2824, UN = 2816, UNP = 3072;
constexpr int U_RQ = 0, U_RK = 256, U_RV = 512, U_RG = 768, U_SZ = 1024, U_XS = 1536, U_AQ = 2304, U_AK = 2560, U_AV = 2688;
constexpr int W_DT = 2304;
constexpr int XBC = 768;
constexpr float LN_EPS = 1e-5f;
constexpr float ALPHA = 1.41421356237309515f;
constexpr int CAPT = 72, CAPR = CAPT * 256;
constexpr size_t CTL_BYTES = 65536, CTL_BAR_OFF = 4096;
constexpr int MAXROWS = (2 * T / 256 + NE) * 256;

#ifdef CPU_EMU
#define DEV static inline
typedef float act_t;
DEV float a2f(act_t v) { return v; }
DEV act_t f2a(float f) { return f; }
DEV int atomic_inc(int* p) { return __sync_fetch_and_add(p, 1); }
#else
#define DEV __device__ __forceinline__
typedef unsigned short act_t;
DEV float a2f(act_t v) { return __uint_as_float(((unsigned)v) << 16); }
DEV act_t f2a(float f) { unsigned u = __float_as_uint(f); return (act_t)((u + 0x7fffu + ((u >> 16) & 1u)) >> 16); }
DEV int atomic_inc(int* p) { return atomicAdd(p, 1); }
#endif

DEV float siluf(float x) { return x / (1.0f + expf(-x)); }
DEV float softplusf(float x) { return x > 20.f ? x : log1pf(expf(x)); }
DEV float loggamma(int h) { return logf(1.0f - exp2f(-5.0f - (float)h)); }

#ifdef CPU_EMU
static const unsigned char
#else
__constant__ unsigned char
#endif
T5B[128] = {0, 1, 2, 3, 4, 5, 6, 7, 8, 9, 10, 11, 12, 13, 14, 15, 16, 16, 16, 17, 17, 18, 18, 18, 19, 19, 19, 20, 20, 20, 20, 21, 21, 21, 21, 22, 22, 22, 22, 22, 23, 23, 23, 23, 23, 23, 24, 24, 24, 24, 24, 24, 25, 25, 25, 25, 25, 25, 25, 26, 26, 26, 26, 26, 26, 26, 26, 27, 27, 27, 27, 27, 27, 27, 27, 27, 27, 28, 28, 28, 28, 28, 28, 28, 28, 28, 28, 29, 29, 29, 29, 29, 29, 29, 29, 29, 29, 29, 29, 30, 30, 30, 30, 30, 30, 30, 30, 30, 30, 30, 30, 30, 30, 31, 31, 31, 31, 31, 31, 31, 31, 31, 31, 31, 31, 31, 31, 31};

struct P {
    const float* x; const float* c; const int* pos; const float* rel_bias; const float* w_ada; const float* b_ada; const float* w_in; const float* w_out;
    const float* conv_w; const float* conv_b; const float* dt_bias; const float* a_log; const float* d_skip; const float* ssd_norm_w; const float* sinks;
    const float* ln_g; const float* ln_b; const float* ffn_wg; const float* ffn_wu; const float* ffn_wd; const float* router_w; const float* router_b;
    const float* ex_wg; const float* ex_wu; const float* ex_wd;
    float* out;
    float* mod;
    float* cs;
    act_t* hb;
    act_t* u;
    float* dtraw;
    float* dt;
    float* acs;
    act_t* xbc;
    float* st_ret;
    float* st_ssd;
    float* cdec;
    act_t* ymix;
    float* gout;
    float* xb;
    act_t* act;
    act_t* ybuf;
    int* cnt;
    int* slot_tok;
    unsigned* bar;
    act_t* win_t; act_t* wout_t; act_t* wgu_t; act_t* wd_t; act_t* egu_t; act_t* ed_t;
    int* top_e;
    int* top_p;
    float* top_w;
};

#define ITEMS(n) for (long it = gtid; it < (long)(n); it += gsz)

DEV void ph_mod(const P& p, long gtid, long gsz) {
    ITEMS(2 * NB * 6 * D) {
        const int n = (int)(it % (6 * D)), b = (int)((it / (6 * D)) % NB), l = (int)(it / (6 * D * NB));
        const float* w = p.w_ada + (size_t)l * D * 6 * D + n; const float* cv = p.c + (size_t)b * D;
        float acc = 0.f;
        for (int k = 0; k < D; ++k) acc += cv[k] * w[(size_t)k * 6 * D];
        p.mod[it] = acc + p.b_ada[l * 6 * D + n];
    }
}
DEV void ph_rotab(const P& p, long gtid, long gsz) {
    ITEMS(T * 32) {
        const int i = (int)(it % 32); const long t = it / 32;
        const float inv = expf((-9.210340371976184f * (float)i) / 32.0f);
        const float ang = (float)p.pos[t] * inv;
        p.cs[t * 64 + i] = (float)cos((double)ang); p.cs[t * 64 + 32 + i] = (float)sin((double)ang);
    }
}
DEV void ph_modulate(const P& p, int layer, const float* xin, int sel, long gtid, long gsz) {
    ITEMS((long)T * D) {
        const int d = (int)(it % D); const long t = it / D; const int b = (int)(t / L);
        const float* m = p.mod + ((size_t)layer * NB + b) * 6 * D + sel * 3 * D;
        p.hb[it] = f2a(xin[it] * (1.0f + m[D + d]) + m[d]);
    }
}
DEV void ph_dtraw(const P& p, int layer, const float* xin, long gtid, long gsz) {
    ITEMS((long)T * 8) {
        const int j = (int)(it % 8); const long t = it / 8; const int b = (int)(t / L);
        const float* m = p.mod + ((size_t)layer * NB + b) * 6 * D; const float* w = p.w_in + (size_t)layer * D * IN_DIM + W_DT + j;
        float acc = 0.f;
        for (int d = 0; d < D; ++d) acc += (xin[t * D + d] * (1.0f + m[D + d]) + m[d]) * w[(size_t)d * IN_DIM];
        p.dtraw[it] = acc;
    }
}
DEV void ph_rotary(const P& p, long gtid, long gsz) {
    ITEMS((long)T * 256) {
        const int i = (int)(it % 32), h = (int)((it / 32) % 4), which = (int)((it / 128) % 2); const long t = it / 256;
        act_t* q = p.u + (size_t)t * UN + (which ? U_RK : U_RQ) + h * 64;
        const float c = p.cs[t * 64 + i], s = p.cs[t * 64 + 32 + i];
        const float t1 = a2f(q[i]), t2 = a2f(q[32 + i]); const float sc = which ? 0.125f : 1.0f;
        q[i] = f2a((t1 * c - t2 * s) * sc); q[32 + i] = f2a((t1 * s + t2 * c) * sc);
    }
}
DEV void ph_conv(const P& p, int layer, long gtid, long gsz) {
    ITEMS((long)T * XBC) {
        const int c = (int)(it % XBC); const long t = it / XBC; const int l = (int)(t % L);
        float acc = p.conv_b[layer * XBC + c];
        for (int w = 0; w < 4; ++w) { const int ll = l - 3 + w; if (ll >= 0) acc += a2f(p.u[(size_t)(t - 3 + w) * UN + U_XS + c]) * p.conv_w[((size_t)layer * 4 + w) * XBC + c]; }
        p.xbc[it] = f2a(siluf(acc));
    }
}
DEV void ph_dt(const P& p, int layer, long gtid, long gsz) {
    ITEMS(NB * NCH * 8) {
        const int hd = (int)(it % 8); const long bc = it / 8;
        const float bias = p.dt_bias[layer * 8 + hd], A = -expf(p.a_log[layer * 8 + hd]);
        float cs = 0.f;
        for (int i = 0; i < CH; ++i) { const long t = bc * CH + i; const float dt = softplusf(p.dtraw[t * 8 + hd] + bias); cs += A * dt; p.dt[t * 8 + hd] = dt; p.acs[t * 8 + hd] = cs; }
        p.cdec[it] = expf(cs);
    }
}
DEV void ph_ret_state(const P& p, long gtid, long gsz) {
    ITEMS((long)NB * NCH * 4 * 4096) {
        const int e = (int)(it % 64), d = (int)((it / 64) % 64), h = (int)((it / 4096) % 4); const long bc = it / (4096 * 4);
        const float lg = loggamma(h); float acc = 0.f;
        for (int j = 0; j < CH; ++j) { const act_t* r = p.u + (size_t)(bc * CH + j) * UN; acc += a2f(r[U_RK + h * 64 + d]) * expf(lg * (float)(CH - 1 - j)) * a2f(r[U_RV + h * 64 + e]); }
        p.st_ret[it] = acc;
    }
}
DEV void ph_ssd_state(const P& p, long gtid, long gsz) {
    ITEMS((long)NB * NCH * 8 * 4096) {
        const int n = (int)(it % 64), pp = (int)((it / 64) % 64), hd = (int)((it / 4096) % 8); const long bc = it / (4096 * 8); const int g = hd / 4;
        const float alast = p.acs[(bc * CH + CH - 1) * 8 + hd]; float acc = 0.f;
        for (int l = 0; l < CH; ++l) { const long t = bc * CH + l; const act_t* r = p.xbc + (size_t)t * XBC;
            acc += a2f(r[512 + g * 64 + n]) * expf(alast - p.acs[t * 8 + hd]) * (a2f(r[hd * 64 + pp]) * p.dt[t * 8 + hd]); }
        p.st_ssd[it] = acc;
    }
}
DEV void ph_scan(const P& p, long gtid, long gsz) {
    ITEMS((long)NB * 4 * 4096 + (long)NB * 8 * 4096) {
        if (it < (long)NB * 4 * 4096) {
            const int el = (int)(it % 4096), h = (int)((it / 4096) % 4), b = (int)(it / (4096 * 4));
            const float dec = expf(loggamma(h) * (float)CH); float S = 0.f;
            for (int c = 0; c < NCH; ++c) { float* q = p.st_ret + (((size_t)b * NCH + c) * 4 + h) * 4096 + el; const float v = *q; *q = S; S = dec * S + v; }
        } else {
            const long i2 = it - (long)NB * 4 * 4096; const int el = (int)(i2 % 4096), hd = (int)((i2 / 4096) % 8), b = (int)(i2 / (4096 * 8));
            float S = 0.f;
            for (int c = 0; c < NCH; ++c) { float* q = p.st_ssd + (((size_t)b * NCH + c) * 8 + hd) * 4096 + el; const float v = *q; *q = S; S = p.cdec[((size_t)b * NCH + c) * 8 + hd] * S + v; }
        }
    }
}
DEV void ph_ret_o(const P& p, long gtid, long gsz) {
    ITEMS((long)T * 256) {
        const int e = (int)(it % 64), h = (int)((it / 64) % 4); const long t = it / 256; const int i = (int)(t % CH); const long bc = t / CH;
        const float lg = loggamma(h); const act_t* qi = p.u + (size_t)t * UN + U_RQ + h * 64;
        float acc = 0.f;
        for (int j = 0; j <= i; ++j) { const act_t* r = p.u + (size_t)(bc * CH + j) * UN; float s = 0.f;
            for (int d = 0; d < 64; ++d) s += a2f(qi[d]) * a2f(r[U_RK + h * 64 + d]);
            acc += s * expf(lg * (float)(i - j)) * a2f(r[U_RV + h * 64 + e]); }
        const float* pv = p.st_ret + ((size_t)bc * 4 + h) * 4096; float cr = 0.f;
        for (int d = 0; d < 64; ++d) cr += a2f(qi[d]) * pv[d * 64 + e];
        p.ymix[(size_t)t * D + h * 64 + e] = f2a(acc + expf(lg * (float)(i + 1)) * cr);
    }
}
DEV void ph_ret_norm(const P& p, long gtid, long gsz) {
    ITEMS((long)T * 4) {
        const int h = (int)(it % 4); const long t = it / 4; act_t* o = p.ymix + (size_t)t * D + h * 64;
        float mu = 0.f; for (int e = 0; e < 64; ++e) mu += a2f(o[e]); mu *= (1.0f / 64.0f);
        float var = 0.f; for (int e = 0; e < 64; ++e) { const float dlt = a2f(o[e]) - mu; var += dlt * dlt; } var *= (1.0f / 64.0f);
        const float rs = 1.0f / sqrtf(var + LN_EPS);
        for (int e = 0; e < 64; ++e) { const float g = a2f(p.u[(size_t)t * UN + U_RG + h * 64 + e]); o[e] = f2a(siluf(g) * ((a2f(o[e]) - mu) * rs)); }
    }
}
DEV void ph_ssd_y(const P& p, int layer, long gtid, long gsz) {
    ITEMS((long)T * 512) {
        const int pp = (int)(it % 64), hd = (int)((it / 64) % 8); const long t = it / 512; const int l = (int)(t % CH); const long bc = t / CH; const int g = hd / 4;
        const act_t* rl = p.xbc + (size_t)t * XBC; const float al = p.acs[t * 8 + hd];
        float acc = 0.f;
        for (int s = 0; s <= l; ++s) { const long ts = bc * CH + s; const act_t* rs = p.xbc + (size_t)ts * XBC; float cb = 0.f;
            for (int n = 0; n < 64; ++n) cb += a2f(rl[640 + g * 64 + n]) * a2f(rs[512 + g * 64 + n]);
            acc += cb * expf(al - p.acs[ts * 8 + hd]) * (a2f(rs[hd * 64 + pp]) * p.dt[ts * 8 + hd]); }
        const float* pv = p.st_ssd + ((size_t)bc * 8 + hd) * 4096 + pp * 64; float off = 0.f;
        for (int n = 0; n < 64; ++n) off += a2f(rl[640 + g * 64 + n]) * pv[n];
        p.ymix[(size_t)t * D + 256 + hd * 64 + pp] = f2a(acc + off * expf(al) + a2f(rl[hd * 64 + pp]) * p.d_skip[layer * 8 + hd]);
    }
}
DEV void ph_ssd_norm(const P& p, int layer, long gtid, long gsz) {
    ITEMS((long)T * 2) {
        const int g = (int)(it % 2); const long t = it / 2;
        float ms = 0.f;
        for (int k = 0; k < 256; ++k) { const int ch = g * 256 + k; const float hv = a2f(p.ymix[(size_t)t * D + 256 + ch]) * siluf(a2f(p.u[(size_t)t * UN + U_SZ + ch])); ms += hv * hv; }
        const float rs = 1.0f / sqrtf(ms * (1.0f / 256.0f) + LN_EPS);
        for (int k = 0; k < 256; ++k) { const int ch = g * 256 + k; const float hv = a2f(p.ymix[(size_t)t * D + 256 + ch]) * siluf(a2f(p.u[(size_t)t * UN + U_SZ + ch]));
            p.ymix[(size_t)t * D + 256 + ch] = f2a(hv * rs * p.ssd_norm_w[layer * 512 + ch]); }
    }
}
DEV void ph_swa(const P& p, int layer, long gtid, long gsz) {
    ITEMS((long)T * 256) {
        const int d = (int)(it % 64), hq = (int)((it / 64) % 4); const long t = it / 256; const int l = (int)(t % L); const int kvh = hq / 2;
        const act_t* q = p.u + (size_t)t * UN + U_AQ + hq * 64;
        float m = p.sinks[layer * 4 + hq], den = 1.0f, acc = 0.f;
        const int j0 = l - 127 > 0 ? l - 127 : 0;
        for (int j = j0; j <= l; ++j) { const act_t* r = p.u + (size_t)(t - l + j) * UN; float s = 0.f;
            for (int dd = 0; dd < 64; ++dd) s += a2f(q[dd]) * a2f(r[U_AK + kvh * 64 + dd]);
            s = s * 0.125f + p.rel_bias[T5B[l - j] * 4 + hq];
            if (s > m) { const float sc = expf(m - s); den *= sc; acc *= sc; m = s; }
            const float pr = expf(s - m); den += pr; acc += pr * a2f(r[U_AV + kvh * 64 + d]); }
        p.ymix[(size_t)t * D + 768 + hq * 64 + d] = f2a(acc / den);
    }
}
DEV int moe_rb(const P& p, int e) { int acc = 0; for (int k = 0; k < NE; ++k) if (k < e) acc += (p.cnt[k] + 255) / 256 * 256; return acc; }
DEV float ln_fval(const P& p, int fsrc, long t, int d, size_t r0, size_t r1) {
    if (fsrc == 0) return p.gout[t * D + d];
    return p.top_w[t * 2] * a2f(p.ybuf[r0 * D + d]) + p.top_w[t * 2 + 1] * a2f(p.ybuf[r1 * D + d]);
}
DEV void ph_ln(const P& p, int layer, int which, const float* xin, float* xout, int fsrc, int hl, int hsel, long gtid, long gsz) {
    ITEMS(T) {
        const long t = it; const int b = (int)(t / L);
        size_t r0 = 0, r1 = 0; if (fsrc == 1) { r0 = (size_t)moe_rb(p, p.top_e[t * 2]) + p.top_p[t * 2]; r1 = (size_t)moe_rb(p, p.top_e[t * 2 + 1]) + p.top_p[t * 2 + 1]; }
        const float* gate = p.mod + ((size_t)layer * NB + b) * 6 * D + (which ? 5 : 2) * D;
        float mu = 0.f; for (int d = 0; d < D; ++d) mu += ALPHA * xin[t * D + d] + (1.0f + gate[d]) * ln_fval(p, fsrc, t, d, r0, r1); mu *= (1.0f / D);
        float var = 0.f; for (int d = 0; d < D; ++d) { const float v = ALPHA * xin[t * D + d] + (1.0f + gate[d]) * ln_fval(p, fsrc, t, d, r0, r1) - mu; var += v * v; } var *= (1.0f / D);
        const float rs = 1.0f / sqrtf(var + LN_EPS);
        const float* lg = p.ln_g + ((size_t)layer * 2 + which) * D; const float* lb = p.ln_b + ((size_t)layer * 2 + which) * D;
        const float* m = hl >= 0 ? p.mod + ((size_t)hl * NB + b) * 6 * D + hsel * 3 * D : nullptr;
        for (int d = 0; d < D; ++d) { const float v = ALPHA * xin[t * D + d] + (1.0f + gate[d]) * ln_fval(p, fsrc, t, d, r0, r1);
            const float o = (v - mu) * rs * lg[d] + lb[d]; xout[t * D + d] = o;
            if (m) p.hb[t * D + d] = f2a(o * (1.0f + m[D + d]) + m[d]); }
    }
}
DEV void ph_route(const P& p, int layer, const float* xin, long gtid, long gsz) {
    ITEMS(T) {
        const long t = it; const int b = (int)(t / L);
        const float* m = p.mod + ((size_t)layer * NB + b) * 6 * D + 3 * D;
        float lg0 = 0, lg1 = 0, lg2 = 0, lg3 = 0, lg4 = 0, lg5 = 0, lg6 = 0, lg7 = 0;
        for (int d = 0; d < D; ++d) { const float hv = xin[t * D + d] * (1.0f + m[D + d]) + m[d]; const float* w = p.router_w + (size_t)d * NE;
            lg0 += hv * w[0]; lg1 += hv * w[1]; lg2 += hv * w[2]; lg3 += hv * w[3]; lg4 += hv * w[4]; lg5 += hv * w[5]; lg6 += hv * w[6]; lg7 += hv * w[7]; }
        float v1 = -3.0e38f, v2 = -3.0e38f; int i1 = 0, i2 = 0;
#define RT_STEP(e, val) { const float vv = (val) + p.router_b[e]; if (vv > v1) { v2 = v1; i2 = i1; v1 = vv; i1 = e; } else if (vv > v2) { v2 = vv; i2 = e; } }
        RT_STEP(0, lg0) RT_STEP(1, lg1) RT_STEP(2, lg2) RT_STEP(3, lg3) RT_STEP(4, lg4) RT_STEP(5, lg5) RT_STEP(6, lg6) RT_STEP(7, lg7)
#undef RT_STEP
        const float w1 = 1.0f / (1.0f + expf(v2 - v1));
        const int p1 = atomic_inc(p.cnt + i1), p2 = atomic_inc(p.cnt + i2);
        p.slot_tok[(size_t)i1 * T + p1] = (int)t; p.slot_tok[(size_t)i2 * T + p2] = (int)t;
        p.top_e[t * 2] = i1; p.top_e[t * 2 + 1] = i2; p.top_p[t * 2] = p1; p.top_p[t * 2 + 1] = p2; p.top_w[t * 2] = w1; p.top_w[t * 2 + 1] = 1.0f - w1;
    }
}

struct GG { const act_t* A; int lda; const int* gather; int M; const float* B; const float* B2; int ldb; int skip_at, skip_by; int K; void* C; int ldc; int mode; };
#ifdef CPU_EMU
static void gg_tile(const GG& g, int mt, int nt) {
    for (int r = 0; r < 128; ++r) { const int m = mt * 128 + r; if (m >= g.M) break; const int ar = g.gather ? g.gather[m] : m;
        for (int cc = 0; cc < 64; ++cc) { const int n = nt * 64 + cc, bc = n >= g.skip_at ? n + g.skip_by : n; float a1 = 0.f, a2 = 0.f;
            for (int k = 0; k < g.K; ++k) { const float av = g.A[(size_t)ar * g.lda + k]; a1 += av * g.B[(size_t)k * g.ldb + bc]; if (g.mode == 2) a2 += av * g.B2[(size_t)k * g.ldb + bc]; }
            if (g.mode == 0) ((float*)g.C)[(size_t)m * g.ldc + n] = a1; else ((act_t*)g.C)[(size_t)m * g.ldc + n] = f2a(g.mode == 2 ? siluf(a1) * a2 : a1); } }
}
#else
__device__ __forceinline__ void gg_tile(const GG& g, int mt, int nt, float* sm) {
    float* As = sm; float* Bs = sm + 16 * 132; float* B2s = Bs + 16 * 64;
    const int tid = threadIdx.x, ty = tid >> 4, tx = tid & 15;
    float a1[4][4], a2[4][4];
#pragma unroll
    for (int i = 0; i < 4; ++i)
#pragma unroll
        for (int j = 0; j < 4; ++j) { a1[i][j] = 0.f; a2[i][j] = 0.f; }
    const int ar_ = tid >> 2, ak_ = (tid & 3) * 4; const int am = mt * 128 + ar_; const bool aval = am < g.M;
    const int arow = aval ? (g.gather ? g.gather[am] : am) : 0;
    const act_t* Ap = g.A + (size_t)arow * g.lda + ak_;
    const int bk_ = tid >> 5, bn_ = (tid & 31) * 2; const int n0 = nt * 64 + bn_;
    const int bc0 = n0 >= g.skip_at ? n0 + g.skip_by : n0, bc1 = (n0 + 1) >= g.skip_at ? n0 + 1 + g.skip_by : n0 + 1;
    for (int k0 = 0; k0 < g.K; k0 += 16) {
#pragma unroll
        for (int i = 0; i < 4; ++i) As[(ak_ + i) * 132 + ar_] = aval ? a2f(Ap[k0 + i]) : 0.f;
        const float* bp = g.B + (size_t)(k0 + bk_) * g.ldb; Bs[bk_ * 64 + bn_] = bp[bc0]; Bs[bk_ * 64 + bn_ + 1] = bp[bc1];
        if (g.mode == 2) { const float* bp2 = g.B2 + (size_t)(k0 + bk_) * g.ldb; B2s[bk_ * 64 + bn_] = bp2[bc0]; B2s[bk_ * 64 + bn_ + 1] = bp2[bc1]; }
        __syncthreads();
#pragma unroll
        for (int k = 0; k < 16; ++k) {
            float av[4], bv[4], cv[4];
#pragma unroll
            for (int i = 0; i < 4; ++i) { av[i] = As[k * 132 + ty * 4 + i]; bv[i] = Bs[k * 64 + tx * 4 + i]; cv[i] = g.mode == 2 ? B2s[k * 64 + tx * 4 + i] : 0.f; }
#pragma unroll
            for (int i = 0; i < 4; ++i)
#pragma unroll
                for (int j = 0; j < 4; ++j) { a1[i][j] += av[i] * bv[j]; if (g.mode == 2) a2[i][j] += av[i] * cv[j]; }
        }
        __syncthreads();
    }
#pragma unroll
    for (int i = 0; i < 4; ++i) { const int m = mt * 128 + ty * 4 + i; if (m < g.M) {
#pragma unroll
        for (int j = 0; j < 4; ++j) { const int n = nt * 64 + tx * 4 + j;
            if (g.mode == 0) ((float*)g.C)[(size_t)m * g.ldc + n] = a1[i][j]; else ((act_t*)g.C)[(size_t)m * g.ldc + n] = f2a(g.mode == 2 ? siluf(a1[i][j]) * a2[i][j] : a1[i][j]); } } }
}
#endif

#ifdef CPU_EMU
#define GG_TILE(g, mt, nt) gg_tile(g, mt, nt)
#define SM_ARG
#define SM_PARM
#else
#define GG_TILE(g, mt, nt) gg_tile(g, mt, nt, sm)
#define SM_ARG , sm
#define SM_PARM , float* sm
#endif
DEV void ph_gemm_plain(const GG& g, int N, int bid, int nblk SM_PARM) {
    const int ntn = N / 64, ntm = (g.M + 127) / 128;
    for (int tIdx = bid; tIdx < ntn * ntm; tIdx += nblk) GG_TILE(g, tIdx / ntn, tIdx % ntn);
}
DEV void ph_gemm_moe(const P& p, int which, int pass, int bid, int nblk SM_PARM) {
    const int N = which ? D : DFFE, ntn = N / 64, ntm = T / 128;
    for (long tIdx = bid; tIdx < (long)NE * ntm * ntn; tIdx += nblk) {
        const int nt = (int)(tIdx % ntn), mt = (int)((tIdx / ntn) % ntm), e = (int)(tIdx / ((long)ntn * ntm));
        if (mt * 128 >= p.cnt[e]) continue;
        const int rbe = moe_rb(p, e); const ptrdiff_t arow0 = (ptrdiff_t)rbe - (ptrdiff_t)pass * CAPR;
        const int grow = rbe + mt * 128;
        if (grow < pass * CAPR || grow >= (pass + 1) * CAPR) continue;
        GG g;
        if (which == 0) { g.A = p.hb; g.lda = D; g.gather = p.slot_tok + (size_t)e * T; g.M = p.cnt[e]; g.B = p.ex_wg + (size_t)e * D * DFFE; g.B2 = p.ex_wu + (size_t)e * D * DFFE; g.ldb = DFFE;
            g.skip_at = 1 << 30; g.skip_by = 0; g.K = D; g.C = p.act + arow0 * DFFE; g.ldc = DFFE; g.mode = 2; }
        else { g.A = p.act + arow0 * DFFE; g.lda = DFFE; g.gather = nullptr; g.M = p.cnt[e]; g.B = p.ex_wd + (size_t)e * DFFE * D; g.B2 = nullptr; g.ldb = D;
            g.skip_at = 1 << 30; g.skip_by = 0; g.K = DFFE; g.C = p.ybuf + (size_t)rbe * D; g.ldc = D; g.mode = 1; }
        GG_TILE(g, mt, nt);
    }
}

constexpr size_t al256(size_t v) { return (v + 255) & ~(size_t)255; }
struct WsMap {
    size_t mod, cs, hb, u, dtraw, dt, acs, xbc, st_ret, st_ssd, cdec, ymix, gout, xb, act, ybuf, cnt, slot_tok, top_e, top_p, top_w, win_t, wout_t, wgu_t, wd_t, egu_t, ed_t, end;
};
static WsMap make_map() {
    WsMap m; size_t o = 0;
    const size_t A = sizeof(act_t);
    m.cnt = o; o += CTL_BYTES;
    m.mod = o; o += al256((size_t)2 * NB * 6 * D * 4);
    m.cs = o; o += al256((size_t)T * 64 * 4);
    m.hb = o; o += al256((size_t)T * D * A);
    m.dtraw = o; o += al256((size_t)T * 8 * 4);
    m.dt = o; o += al256((size_t)T * 8 * 4);
    m.acs = o; o += al256((size_t)T * 8 * 4);
    m.cdec = o; o += al256((size_t)NB * NCH * 8 * 4);
    m.xb = o; o += al256((size_t)T * D * 4);
    m.slot_tok = o; o += al256((size_t)NE * T * 4);
    m.top_e = o; o += al256((size_t)T * 2 * 4);
    m.top_p = o; o += al256((size_t)T * 2 * 4);
    m.top_w = o; o += al256((size_t)T * 2 * 4);
    m.win_t = o; o += al256((size_t)2 * UNP * D * A);
    m.wout_t = o; o += al256((size_t)2 * D * D * A);
    m.wgu_t = o; o += al256((size_t)2 * DFF * D * A);
    m.wd_t = o; o += al256((size_t)D * DFF * A);
    m.egu_t = o; o += al256((size_t)NE * 2 * DFFE * D * A);
    m.ed_t = o; o += al256((size_t)NE * D * DFFE * A);
    const size_t r1 = o; size_t r1e = r1;
    m.u = r1; m.ymix = r1 + al256((size_t)T * UN * A); r1e = m.ymix + al256((size_t)T * D * A);
    m.act = r1; { size_t e1 = r1 + al256((size_t)T * DFF * A); if (e1 > r1e) r1e = e1; size_t e2 = r1 + al256((size_t)CAPR * DFFE * A); if (e2 > r1e) r1e = e2; }
    o = r1e;
    const size_t r2 = o; size_t q = r2;
    m.xbc = q; q += al256((size_t)T * XBC * A);
    m.st_ret = q; q += al256((size_t)NB * NCH * 4 * 4096 * 4);
    m.st_ssd = q; q += al256((size_t)NB * NCH * 8 * 4096 * 4);
    m.gout = r2; { size_t e = r2 + al256((size_t)T * D * 4); if (e > q) q = e; }
    m.ybuf = r2; { size_t e = r2 + al256((size_t)MAXROWS * D * A); if (e > q) q = e; }
    o = q;
    m.end = o;
    return m;
}

static void fill_params(P& p, void* const* d_in, void* d_out, void* d_ws, const WsMap& m) {
    p.x = (const float*)d_in[0]; p.c = (const float*)d_in[1]; p.pos = (const int*)d_in[2]; p.rel_bias = (const float*)d_in[3]; p.w_ada = (const float*)d_in[4]; p.b_ada = (const float*)d_in[5];
    p.w_in = (const float*)d_in[6]; p.w_out = (const float*)d_in[7]; p.conv_w = (const float*)d_in[8]; p.conv_b = (const float*)d_in[9]; p.dt_bias = (const float*)d_in[10]; p.a_log = (const float*)d_in[11];
    p.d_skip = (const float*)d_in[12]; p.ssd_norm_w = (const float*)d_in[13]; p.sinks = (const float*)d_in[14]; p.ln_g = (const float*)d_in[15]; p.ln_b = (const float*)d_in[16];
    p.ffn_wg = (const float*)d_in[17]; p.ffn_wu = (const float*)d_in[18]; p.ffn_wd = (const float*)d_in[19]; p.router_w = (const float*)d_in[20]; p.router_b = (const float*)d_in[21];
    p.ex_wg = (const float*)d_in[22]; p.ex_wu = (const float*)d_in[23]; p.ex_wd = (const float*)d_in[24];
    p.out = (float*)d_out;
    char* w = (char*)d_ws;
    p.mod = (float*)(w + m.mod); p.cs = (float*)(w + m.cs); p.hb = (act_t*)(w + m.hb); p.u = (act_t*)(w + m.u); p.dtraw = (float*)(w + m.dtraw); p.dt = (float*)(w + m.dt); p.acs = (float*)(w + m.acs);
    p.xbc = (act_t*)(w + m.xbc); p.st_ret = (float*)(w + m.st_ret); p.st_ssd = (float*)(w + m.st_ssd); p.cdec = (float*)(w + m.cdec);
    p.ymix = (act_t*)(w + m.ymix); p.gout = (float*)(w + m.gout); p.xb = (float*)(w + m.xb); p.act = (act_t*)(w + m.act); p.ybuf = (act_t*)(w + m.ybuf);
    p.win_t = (act_t*)(w + m.win_t); p.wout_t = (act_t*)(w + m.wout_t); p.wgu_t = (act_t*)(w + m.wgu_t); p.wd_t = (act_t*)(w + m.wd_t); p.egu_t = (act_t*)(w + m.egu_t); p.ed_t = (act_t*)(w + m.ed_t);
    p.cnt = (int*)(w + m.cnt); p.bar = (unsigned*)(w + m.cnt + CTL_BAR_OFF); p.slot_tok = (int*)(w + m.slot_tok); p.top_e = (int*)(w + m.top_e); p.top_p = (int*)(w + m.top_p); p.top_w = (float*)(w + m.top_w);
}

enum { PH_MOD = 0, PH_ROTAB, PH_MODUL0, PH_DTRAW, PH_INPROJ, PH_ROTARY, PH_CONV, PH_DT, PH_RSTATE, PH_SSTATE, PH_SCAN, PH_RETO, PH_RETN, PH_SSDY, PH_SSDN, PH_SWA, PH_OUTPROJ, PH_LN1,
       PH_FFN_GU, PH_FFN_DN, PH_LN2, PH_ROUTE, PH_MOE_GU0, PH_MOE_DN0, PH_MOE_GU1, PH_MOE_DN1, PH_LN2M };

template <int ph> DEV void run_phase(const P& p, int layer, long gtid, long gsz, int bid, int nblk SM_PARM) {
    const float* xin = layer == 0 ? p.x : p.xb;
    float* x1 = p.out;
    if constexpr (ph == PH_MOD) ph_mod(p, gtid, gsz);
    if constexpr (ph == PH_ROTAB) ph_rotab(p, gtid, gsz);
    if constexpr (ph == PH_MODUL0) ph_modulate(p, 0, p.x, 0, gtid, gsz);
    if constexpr (ph == PH_DTRAW) ph_dtraw(p, layer, xin, gtid, gsz);
    if constexpr (ph == PH_INPROJ) { GG g; g.A = p.hb; g.lda = D; g.gather = nullptr; g.M = T; g.B = p.w_in + (size_t)layer * D * IN_DIM; g.B2 = nullptr; g.ldb = IN_DIM; g.skip_at = W_DT; g.skip_by = 8; g.K = D; g.C = p.u; g.ldc = UN; g.mode = 1;
        ph_gemm_plain(g, UN, bid, nblk SM_ARG); }
    if constexpr (ph == PH_ROTARY) ph_rotary(p, gtid, gsz);
    if constexpr (ph == PH_CONV) ph_conv(p, layer, gtid, gsz);
    if constexpr (ph == PH_DT) ph_dt(p, layer, gtid, gsz);
    if constexpr (ph == PH_RSTATE) ph_ret_state(p, gtid, gsz);
    if constexpr (ph == PH_SSTATE) ph_ssd_state(p, gtid, gsz);
    if constexpr (ph == PH_SCAN) ph_scan(p, gtid, gsz);
    if constexpr (ph == PH_RETO) ph_ret_o(p, gtid, gsz);
    if constexpr (ph == PH_RETN) ph_ret_norm(p, gtid, gsz);
    if constexpr (ph == PH_SSDY) ph_ssd_y(p, layer, gtid, gsz);
    if constexpr (ph == PH_SSDN) ph_ssd_norm(p, layer, gtid, gsz);
    if constexpr (ph == PH_SWA) ph_swa(p, layer, gtid, gsz);
    if constexpr (ph == PH_OUTPROJ) { GG g; g.A = p.ymix; g.lda = D; g.gather = nullptr; g.M = T; g.B = p.w_out + (size_t)layer * D * D; g.B2 = nullptr; g.ldb = D; g.skip_at = 1 << 30; g.skip_by = 0; g.K = D; g.C = p.gout; g.ldc = D; g.mode = 0;
        ph_gemm_plain(g, D, bid, nblk SM_ARG); }
    if constexpr (ph == PH_LN1) ph_ln(p, layer, 0, xin, x1, 0, layer, 1, gtid, gsz);
    if constexpr (ph == PH_FFN_GU) { GG g; g.A = p.hb; g.lda = D; g.gather = nullptr; g.M = T; g.B = p.ffn_wg; g.B2 = p.ffn_wu; g.ldb = DFF; g.skip_at = 1 << 30; g.skip_by = 0; g.K = D; g.C = p.act; g.ldc = DFF; g.mode = 2;
        ph_gemm_plain(g, DFF, bid, nblk SM_ARG); }
    if constexpr (ph == PH_FFN_DN) { GG g; g.A = p.act; g.lda = DFF; g.gather = nullptr; g.M = T; g.B = p.ffn_wd; g.B2 = nullptr; g.ldb = D; g.skip_at = 1 << 30; g.skip_by = 0; g.K = DFF; g.C = p.gout; g.ldc = D; g.mode = 0;
        ph_gemm_plain(g, D, bid, nblk SM_ARG); }
    if constexpr (ph == PH_LN2) ph_ln(p, layer, 1, x1, p.xb, 0, 1, 0, gtid, gsz);
    if constexpr (ph == PH_ROUTE) ph_route(p, layer, x1, gtid, gsz);
    if constexpr (ph == PH_MOE_GU0) ph_gemm_moe(p, 0, 0, bid, nblk SM_ARG);
    if constexpr (ph == PH_MOE_DN0) ph_gemm_moe(p, 1, 0, bid, nblk SM_ARG);
    if constexpr (ph == PH_MOE_GU1) ph_gemm_moe(p, 0, 1, bid, nblk SM_ARG);
    if constexpr (ph == PH_MOE_DN1) ph_gemm_moe(p, 1, 1, bid, nblk SM_ARG);
    if constexpr (ph == PH_LN2M) ph_ln(p, layer, 1, x1, p.out, 1, -1, 0, gtid, gsz);
}

static const int PROGRAM[][2] = {
    {PH_MOD, 0}, {PH_ROTAB, 0}, {PH_MODUL0, 0},
    {PH_DTRAW, 0}, {PH_INPROJ, 0}, {PH_ROTARY, 0}, {PH_CONV, 0}, {PH_DT, 0}, {PH_RSTATE, 0}, {PH_SSTATE, 0}, {PH_SCAN, 0}, {PH_RETO, 0}, {PH_RETN, 0}, {PH_SSDY, 0}, {PH_SSDN, 0}, {PH_SWA, 0},
    {PH_OUTPROJ, 0}, {PH_LN1, 0}, {PH_FFN_GU, 0}, {PH_FFN_DN, 0}, {PH_LN2, 0},
    {PH_DTRAW, 1}, {PH_INPROJ, 1}, {PH_ROTARY, 1}, {PH_CONV, 1}, {PH_DT, 1}, {PH_RSTATE, 1}, {PH_SSTATE, 1}, {PH_SCAN, 1}, {PH_RETO, 1}, {PH_RETN, 1}, {PH_SSDY, 1}, {PH_SSDN, 1}, {PH_SWA, 1},
    {PH_OUTPROJ, 1}, {PH_LN1, 1}, {PH_ROUTE, 1}, {PH_MOE_GU0, 1}, {PH_MOE_DN0, 1}, {PH_MOE_GU1, 1}, {PH_MOE_DN1, 1}, {PH_LN2M, 1},
};
constexpr int NPROG = sizeof(PROGRAM) / sizeof(PROGRAM[0]);

#ifndef CPU_EMU
#define XB_TMO      128
#define XB_XCNT(j)  (256  + 64 * (j))
#define XB_XSUB(j)  (1280 + 64 * (j))
#define XB_XGEN(j)  (2304 + 64 * (j))
#define XB_TOP      3328
#define XB_TOPGEN   3392
#define XCD_BAR_WORDS 3456
#define XB_SPIN_CAP (1u << 18)
#define LAS __attribute__((address_space(3)))

__device__ __forceinline__ unsigned xb_ld(unsigned* p)              { return __hip_atomic_load(p, __ATOMIC_RELAXED, __HIP_MEMORY_SCOPE_AGENT); }
__device__ __forceinline__ unsigned xb_add(unsigned* p, unsigned v) { return __hip_atomic_fetch_add(p, v, __ATOMIC_RELAXED, __HIP_MEMORY_SCOPE_AGENT); }
__device__ __forceinline__ unsigned xb_xcc_id() { return (unsigned)__builtin_amdgcn_s_getreg((3 << 11) | 20) & 0xFu; }
#define XB_SPIN(cond, bar) do { unsigned _sp = 0; while (cond) { __builtin_amdgcn_s_sleep(1); \
    if ((++_sp & 255u) == 0u) { if (xb_ld(&(bar)[XB_TMO])) break; if (_sp > XB_SPIN_CAP) { atomicAdd(&(bar)[XB_TMO], 1u); break; } } } } while (0)

struct XcdBarrier {
    unsigned* bar; unsigned x;
    volatile LAS unsigned* st;
};
__device__ __forceinline__ XcdBarrier xcd_barrier_post(unsigned* bar, volatile LAS unsigned* st) {
    XcdBarrier b; b.bar = bar; b.x = xb_xcc_id(); b.st = st;
    if (threadIdx.x == 0) (void)xb_add(&bar[XB_XCNT(b.x)], 1u);
    return b;
}
__device__ __forceinline__ void xcd_barrier_complete(unsigned* bar, unsigned x, unsigned& nloc, unsigned& nx) {
    const unsigned G = gridDim.x * gridDim.y * gridDim.z;
    unsigned sum, cnt, mine, sp = 0u;
    for (;;) {
        sum = 0u; cnt = 0u; mine = 0u;
#pragma unroll
        for (unsigned j = 0; j < 16; ++j) { const unsigned c = xb_ld(&bar[XB_XCNT(j)]); sum += c; cnt += (c > 0u) ? 1u : 0u; mine = (j == x) ? c : mine; }
        if (sum == G) break;
        __builtin_amdgcn_s_sleep(1);
        if ((++sp & 255u) == 0u) { if (xb_ld(&bar[XB_TMO])) break; if (sp > XB_SPIN_CAP) { atomicAdd(&bar[XB_TMO], 1u); break; } }
    }
    nloc = mine > 0u ? mine : 1u; nx = cnt > 0u ? cnt : 1u;
}
__device__ __forceinline__ void xcd_barrier(const XcdBarrier& b) {
    asm volatile("s_waitcnt vmcnt(0)" ::: "memory");
    __syncthreads();
    if (threadIdx.x == 0) {
        unsigned* bar = b.bar;
        __builtin_amdgcn_s_waitcnt(0);
        unsigned nloc = b.st[0], nx = b.st[1];
        if (nloc == 0u) { xcd_barrier_complete(bar, b.x, nloc, nx); b.st[0] = nloc; b.st[1] = nx; }
        const unsigned old = xb_add(&bar[XB_XSUB(b.x)], 1u);
        const unsigned gen = old / nloc;
        if (old + 1u == (gen + 1u) * nloc) {
            __builtin_amdgcn_fence(__ATOMIC_RELEASE, "agent");
            asm volatile("s_waitcnt vmcnt(0)" ::: "memory");
            const unsigned og = xb_add(&bar[XB_TOP], 1u);
            const unsigned tg = og / nx;
            if (og + 1u == (tg + 1u) * nx) xb_add(&bar[XB_TOPGEN], 1u);
            else XB_SPIN(xb_ld(&bar[XB_TOPGEN]) == tg, bar);
            __builtin_amdgcn_fence(__ATOMIC_ACQUIRE, "agent");
            xb_add(&bar[XB_XGEN(b.x)], 1u);
            asm volatile("s_waitcnt vmcnt(0)" ::: "memory");
        } else {
            XB_SPIN(xb_ld(&bar[XB_XGEN(b.x)]) == gen, bar);
            __builtin_amdgcn_fence(__ATOMIC_ACQUIRE, "agent");
            asm volatile("s_waitcnt vmcnt(0)" ::: "memory");
        }
    }
    __syncthreads();
}

__device__ __forceinline__ int ltid() { int t = threadIdx.x; asm volatile("" : "+v"(t)); return t; }

namespace pg8 {
#define PG8_LAS __attribute__((address_space(3)))
typedef unsigned short bf16_t;
typedef short bf16x8 __attribute__((ext_vector_type(8)));
typedef float f32x4 __attribute__((ext_vector_type(4)));
typedef unsigned u32x4 __attribute__((ext_vector_type(4)));
constexpr int BM = 256, BK = 64, HALF = 128, HTB = HALF * BK * 2  , STAGE_BYTES = 8 * HTB, NXCD = 8, WGM = 8;

__host__ __device__ __forceinline__ int lds_byte(int r, int c) { const int st = (r >> 4) * 2 + (c >> 5), rr = r & 15, cc = c & 31, ob = rr * 64 + cc * 2; return st * 1024 + (ob ^ (((ob >> 9) & 1) << 5)); }
__host__ __device__ __forceinline__ void stage_rc(int b, int& R, int& C) { const int st = b / 1024, sb = b % 1024, swz = sb ^ (((sb >> 9) & 1) << 5); R = (st >> 1) * 16 + swz / 64; C = (st & 1) * 32 + (swz % 64) / 2; }
__host__ __device__ __forceinline__ int perm32(int rho) { const int n = rho >> 4, i = rho & 15; return 8 * (i >> 2) + 4 * n + (i & 3); }

struct Unit { int pm, pn, am, e, rt; };

__device__ __forceinline__ bool static_deal(int i, int G, int c, int nM, int nN, int& pm, int& pn) {
    const int nwg = nM * nN; const long Lx = (long)i * G + c; if (Lx >= nwg) return false;
    int wgid = (int)Lx; { const int q = nwg / NXCD, r = nwg % NXCD, xcd = wgid % NXCD, off = wgid / NXCD; wgid = (xcd < r ? xcd * (q + 1) : r * (q + 1) + (xcd - r) * q) + off; }
    const int nig = WGM * nN, gid = wgid / nig, fm = gid * WGM, gsz = (nM - fm) < WGM ? (nM - fm) : WGM;
    pm = fm + ((wgid % nig) % gsz); pn = (wgid % nig) / gsz; return true;
}
struct StaticOrder {
    const char* A; const char* Bt; size_t tstepA, tstepB; int nM, nN, G, c;
    __device__ __forceinline__ void init(const bf16_t* A_, const bf16_t* Bt_, int M, int N, int K, int G_, int c_) { A = (const char*)A_; Bt = (const char*)Bt_; tstepA = tstepB = (size_t)BM * K * 2; nM = M / BM; nN = N / BM; G = G_; c = c_; }
    __device__ __forceinline__ bool next(int i, Unit& u) const { int pm, pn; if (!static_deal(i, G, c, nM, nN, pm, pn)) return false; u.pm = pm; u.pn = pn; u.am = pm; u.e = 0; u.rt = pm; return true; }
    __device__ __forceinline__ const char* a_ptr(const Unit& u) const { return A + (size_t)u.am * tstepA; }
    __device__ __forceinline__ const char* b_ptr(const Unit& u) const { return Bt + (size_t)u.pn * tstepB; }
    __device__ __forceinline__ unsigned tok(const Unit&, int) const { return 0u; }
};
struct MoeOrder {
    const PG8_LAS int* tab; const char* A; const char* Bt; const int* slot_tok; size_t tstepA, tstepB, estepB; int nM, nN, G, c, rt0, which;
    __device__ __forceinline__ bool next(int i, Unit& u) const {
        int pm, pn; if (!static_deal(i, G, c, nM, nN, pm, pn)) return false;
        const int rt = rt0 + pm; int e = 0;
#pragma unroll
        for (int k = 1; k < 8; ++k) e += (rt >= tab[k]) ? 1 : 0;
        u.pn = pn; u.am = pm; u.e = e; u.rt = rt; u.pm = which ? rt : pm; return true;
    }
    __device__ __forceinline__ const char* a_ptr(const Unit& u) const { return which ? A + (size_t)u.am * tstepA : A; }
    __device__ __forceinline__ const char* b_ptr(const Unit& u) const { return Bt + (size_t)u.e * estepB + (size_t)u.pn * tstepB; }
    __device__ __forceinline__ unsigned tok(const Unit& u, int row) const {
        const int slot = (u.rt - tab[u.e]) * BM + row; return slot < tab[16 + u.e] ? (unsigned)slot_tok[(size_t)u.e * T + slot] : 0u;
    }
};

__device__ __forceinline__ unsigned cvt_pk_bf16(float lo, float hi) { unsigned r; asm volatile("v_cvt_pk_bf16_f32 %0, %1, %2" : "=v"(r) : "v"(lo), "v"(hi)); return r; }
struct EpiF32 {
    static constexpr bool PERM = false;
    float* C; int ldc;
    __device__ __forceinline__ void operator()(const f32x4 (&acc)[2][2][4][2], const Unit& u, int wr, int wc, int fr, int fq) const {
        const int row0 = u.pm * BM + wr * 64 + fr, col0 = u.pn * BM + wc * 32 + 4 * fq;
#pragma unroll
        for (int ai = 0; ai < 2; ++ai)
#pragma unroll
            for (int m = 0; m < 4; ++m) { float* rowp = C + (size_t)(row0 + ai * HALF + m * 16) * ldc + col0;
#pragma unroll
                for (int bj = 0; bj < 2; ++bj)
#pragma unroll
                    for (int n = 0; n < 2; ++n) *(f32x4*)(rowp + bj * HALF + n * 16) = acc[ai][bj][m][n]; }
    }
};
struct EpiBf16 {
    static constexpr bool PERM = true;
    bf16_t* O; int ldc;
    __device__ __forceinline__ void operator()(const f32x4 (&acc)[2][2][4][2], const Unit& u, int wr, int wc, int fr, int fq) const {
        const int row0 = u.pm * BM + wr * 64 + fr, col0 = u.pn * BM + wc * 32 + 8 * fq;
#pragma unroll
        for (int ai = 0; ai < 2; ++ai)
#pragma unroll
            for (int m = 0; m < 4; ++m) { bf16_t* rowp = O + (size_t)(row0 + ai * HALF + m * 16) * ldc + col0;
#pragma unroll
                for (int bj = 0; bj < 2; ++bj) { const f32x4 v0 = acc[ai][bj][m][0], v1 = acc[ai][bj][m][1];
                    u32x4 w; w.x = cvt_pk_bf16(v0[0], v0[1]); w.y = cvt_pk_bf16(v0[2], v0[3]); w.z = cvt_pk_bf16(v1[0], v1[1]); w.w = cvt_pk_bf16(v1[2], v1[3]);
                    *(u32x4*)(rowp + bj * HALF) = w; } }
    }
};
struct EpiInproj {
    static constexpr bool PERM = true;
    bf16_t* O; float* dtraw;
    __device__ __forceinline__ void operator()(const f32x4 (&acc)[2][2][4][2], const Unit& u, int wr, int wc, int fr, int fq) const {
        if (u.pn < UN / BM) { EpiBf16 e{O, UN}; e(acc, u, wr, wc, fr, fq); }
        else if (wc == 0 && fq == 0) {
#pragma unroll
            for (int ai = 0; ai < 2; ++ai)
#pragma unroll
                for (int m = 0; m < 4; ++m) { float* dp = dtraw + (size_t)(u.pm * BM + wr * 64 + fr + ai * HALF + m * 16) * 8; *(f32x4*)dp = acc[ai][0][m][0]; *(f32x4*)(dp + 4) = acc[ai][0][m][1]; } }
    }
};
__device__ __forceinline__ float silu_fast(float x) { return x * __builtin_amdgcn_rcpf(1.0f + __builtin_amdgcn_exp2f(-1.4426950408889634f * x)); }
struct EpiSwiglu {
    static constexpr bool PERM = true;
    bf16_t* O; int ldc;
    __device__ __forceinline__ void operator()(const f32x4 (&acc)[2][2][4][2], const Unit& u, int wr, int wc, int fr, int fq) const {
        const int row0 = u.pm * BM + wr * 64 + fr, col0 = u.pn * HALF + wc * 32 + 8 * fq;
#pragma unroll
        for (int ai = 0; ai < 2; ++ai)
#pragma unroll
            for (int m = 0; m < 4; ++m) { bf16_t* rowp = O + (size_t)(row0 + ai * HALF + m * 16) * ldc + col0;
                const f32x4 g0 = acc[ai][0][m][0], g1 = acc[ai][0][m][1], u0 = acc[ai][1][m][0], u1 = acc[ai][1][m][1];
                float v[8];
#pragma unroll
                for (int j = 0; j < 4; ++j) { v[j] = silu_fast(g0[j]) * u0[j]; v[4 + j] = silu_fast(g1[j]) * u1[j]; }
                u32x4 w; w.x = cvt_pk_bf16(v[0], v[1]); w.y = cvt_pk_bf16(v[2], v[3]); w.z = cvt_pk_bf16(v[4], v[5]); w.w = cvt_pk_bf16(v[6], v[7]);
                *(u32x4*)rowp = w; }
    }
};

template <class Epi, class Sched, bool ALIGN_EPI, bool GATHER>
__device__ __forceinline__ void gemm_phase(PG8_LAS unsigned char* lds, const int K, const Sched& S, const Epi& E) {
    const int tid = ltid(), wid = __builtin_amdgcn_readfirstlane(tid >> 6), lane = tid & 63, wr = wid >> 2, wc = wid & 3, fr = lane & 15, fq = lane >> 4;
    const int nt = K / BK;
    unsigned voffA[2], voffB[2], cb[2];
#pragma unroll
    for (int i = 0; i < 2; ++i) { int R, C; stage_rc(tid * 16 + i * 8192, R, C); const int Rb = Epi::PERM ? ((R & ~31) + perm32(R & 31)) : R; cb[i] = (unsigned)C * 2u;
        voffA[i] = (unsigned)(R * K + C) * 2u; voffB[i] = (unsigned)(Rb * K + C) * 2u; }
    const size_t kstep = (size_t)(BK * 2);
    const size_t hstep = (size_t)HALF * K * 2;
    const unsigned ldsw = (unsigned)wid * 1024u;
    const int aoff = lds_byte(wr * 64 + fr, fq * 8), boff = lds_byte(wc * 32 + fr, fq * 8);
#define PG8_SA(b, h) (((b) * 2 + (h)) * HTB)
#define PG8_SB(b, h) ((4 + (b) * 2 + (h)) * HTB)
#define PG8_GLDS(src, dstoff) __builtin_amdgcn_global_load_lds((const unsigned*)(src), (PG8_LAS unsigned*)(lds + (dstoff)), 16, 0, 0)
#define PG8_STAGE(bufoff, gbase, voff) do { PG8_GLDS((const char*)(gbase) + (voff)[0], (bufoff) + ldsw); PG8_GLDS((const char*)(gbase) + (voff)[1], (bufoff) + ldsw + 8192); } while (0)
#define PG8_STAGE_A(bufoff, kp, h, nx) do { if constexpr (GATHER) { const unsigned tk_ = (nx) ? gn[h] : gc[h]; const unsigned o0_ = (tk_ & 0xffffu) * (unsigned)(K * 2) + cb[0], o1_ = (tk_ >> 16) * (unsigned)(K * 2) + cb[1]; \
        PG8_GLDS((const char*)(kp) + o0_, (bufoff) + ldsw); PG8_GLDS((const char*)(kp) + o1_, (bufoff) + ldsw + 8192); } \
        else { PG8_STAGE(bufoff, (const char*)(kp) + (h) * hstep, voffA); } } while (0)
#define PG8_LDA(dst, b, h) do { _Pragma("unroll") for (int m = 0; m < 4; ++m) _Pragma("unroll") for (int k = 0; k < 2; ++k) dst[m][k] = *(const PG8_LAS bf16x8*)(lds + PG8_SA(b, h) + aoff + m * 2048 + k * 1024); } while (0)
#define PG8_LDB(dst, b, h) do { _Pragma("unroll") for (int n = 0; n < 2; ++n) _Pragma("unroll") for (int k = 0; k < 2; ++k) dst[n][k] = *(const PG8_LAS bf16x8*)(lds + PG8_SB(b, h) + boff + n * 2048 + k * 1024); } while (0)
#define PG8_MMA(ai, bj, At, Bt) do { __builtin_amdgcn_s_setprio(1); _Pragma("unroll") for (int m = 0; m < 4; ++m) _Pragma("unroll") for (int n = 0; n < 2; ++n) _Pragma("unroll") for (int k = 0; k < 2; ++k) \
        acc[ai][bj][m][n] = __builtin_amdgcn_mfma_f32_16x16x32_bf16(Bt[n][k], At[m][k], acc[ai][bj][m][n], 0, 0, 0); __builtin_amdgcn_s_setprio(0); } while (0)
#define PG8_WAIT_V(n) asm volatile("s_waitcnt vmcnt(" #n ")" ::: "memory")
#define PG8_WAIT_L(n) asm volatile("s_waitcnt lgkmcnt(" #n ")" ::: "memory")
#define PG8_BAR __builtin_amdgcn_s_barrier()
#define PG8_SCHED __builtin_amdgcn_sched_barrier(0)
#define PG8_GOFF(dst, u_) do { int R0_, R1_, C_; stage_rc(tid * 16, R0_, C_); stage_rc(tid * 16 + 8192, R1_, C_); \
        _Pragma("unroll") for (int h_ = 0; h_ < 2; ++h_) dst[h_] = S.tok(u_, h_ * HALF + R0_) | (S.tok(u_, h_ * HALF + R1_) << 16); \
        asm volatile("" : "+v"(dst[0]), "+v"(dst[1])); } while (0)
    Unit cur, nxt; int ui = 0;
    if (!S.next(0, cur)) return;
    unsigned gc[2] = {0u, 0u}, gn[2] = {0u, 0u};
    if constexpr (GATHER) PG8_GOFF(gc, cur);
    f32x4 acc[2][2][4][2];
#pragma unroll
    for (int a = 0; a < 2; ++a)
#pragma unroll
        for (int b = 0; b < 2; ++b)
#pragma unroll
            for (int m = 0; m < 4; ++m)
#pragma unroll
                for (int n = 0; n < 2; ++n) acc[a][b][m][n] = (f32x4){0.f, 0.f, 0.f, 0.f};
    bf16x8 At[4][2], B0[2][2], B1[2][2];
    const char* cA = S.a_ptr(cur); const char* cB = S.b_ptr(cur);
    PG8_STAGE(PG8_SB(0, 0), cB, voffB); PG8_STAGE(PG8_SB(0, 1), cB + hstep, voffB); PG8_STAGE_A(PG8_SA(0, 0), cA, 0, false); PG8_STAGE_A(PG8_SA(0, 1), cA, 1, false);
    if (wr == 1) PG8_BAR;
    PG8_WAIT_V(2); PG8_BAR;
    PG8_STAGE(PG8_SB(1, 0), cB + kstep, voffB); PG8_STAGE_A(PG8_SA(1, 0), cA + kstep, 0, false); PG8_STAGE(PG8_SB(1, 1), cB + hstep + kstep, voffB);
    PG8_WAIT_V(6); PG8_BAR;
    for (;;) {
        const bool has_next = S.next(ui + 1, nxt);
        if constexpr (GATHER) { if (has_next) PG8_GOFF(gn, nxt); else { gn[0] = gc[0]; gn[1] = gc[1]; } }
        const char* nA = has_next ? S.a_ptr(nxt) : cA; const char* nB = has_next ? S.b_ptr(nxt) : cB;
        for (int t = 0; t < nt; t += 2) {
            const bool last = (t == nt - 2);
            const char* a1 = cA + (size_t)(t + 1) * kstep;
            const char* a2 = last ? nA : cA + (size_t)(t + 2) * kstep; const char* b2 = last ? nB : cB + (size_t)(t + 2) * kstep;
            const char* a3 = a2 + kstep; const char* b3 = b2 + kstep;
            PG8_LDB(B0, 0, 0); PG8_LDB(B1, 0, 1); PG8_SCHED; PG8_LDA(At, 0, 0); PG8_STAGE_A(PG8_SA(1, 1), a1, 1, false);
            PG8_WAIT_V(8); PG8_WAIT_L(0); PG8_BAR; PG8_MMA(0, 0, At, B0); PG8_MMA(0, 1, At, B1); PG8_BAR; PG8_SCHED;
            PG8_LDA(At, 0, 1); PG8_STAGE(PG8_SB(0, 0), b2, voffB); PG8_STAGE(PG8_SB(0, 1), b2 + hstep, voffB); PG8_STAGE_A(PG8_SA(0, 0), a2, 0, last);
            PG8_WAIT_V(8); PG8_WAIT_L(0); PG8_BAR; PG8_MMA(1, 0, At, B0); PG8_MMA(1, 1, At, B1); PG8_BAR; PG8_SCHED;
            PG8_LDB(B0, 1, 0); PG8_LDB(B1, 1, 1); PG8_SCHED; PG8_LDA(At, 1, 0); PG8_STAGE_A(PG8_SA(0, 1), a2, 1, last);
            PG8_WAIT_V(8); PG8_WAIT_L(0); PG8_BAR; PG8_MMA(0, 0, At, B0); PG8_MMA(0, 1, At, B1); PG8_BAR; PG8_SCHED;
            PG8_LDA(At, 1, 1); PG8_STAGE(PG8_SB(1, 0), b3, voffB); PG8_STAGE(PG8_SB(1, 1), b3 + hstep, voffB); PG8_STAGE_A(PG8_SA(1, 0), a3, 0, last);
            PG8_WAIT_V(8); PG8_WAIT_L(0); PG8_BAR; PG8_MMA(1, 0, At, B0); PG8_MMA(1, 1, At, B1); PG8_BAR; PG8_SCHED;
        }
        if constexpr (ALIGN_EPI) { if (wr == 0) PG8_BAR; }
        E(acc, cur, wr, wc, fr, fq);
        if (!has_next) break;
#pragma unroll
        for (int a = 0; a < 2; ++a)
#pragma unroll
            for (int b = 0; b < 2; ++b)
#pragma unroll
                for (int m = 0; m < 4; ++m)
#pragma unroll
                    for (int n = 0; n < 2; ++n) acc[a][b][m][n] = (f32x4){0.f, 0.f, 0.f, 0.f};
        cur = nxt; cA = nA; cB = nB; ++ui;
        if constexpr (GATHER) { gc[0] = gn[0]; gc[1] = gn[1]; }
        if constexpr (ALIGN_EPI) { if (wr == 1) PG8_BAR; }
    }
    PG8_WAIT_V(0);
    if constexpr (!ALIGN_EPI) { if (wr == 0) PG8_BAR; }
    PG8_BAR;
#undef PG8_SA
#undef PG8_SB
#undef PG8_GLDS
#undef PG8_STAGE
#undef PG8_STAGE_A
#undef PG8_LDA
#undef PG8_LDB
#undef PG8_MMA
#undef PG8_WAIT_V
#undef PG8_WAIT_L
#undef PG8_BAR
#undef PG8_SCHED
#undef PG8_GOFF
}
}

constexpr int LDS_BYTES = 147456, LDS_CTL_OFF = 131072, LDS_BAR_OFF = LDS_CTL_OFF + 64, LDS_MOE_OFF = LDS_CTL_OFF + 256;
typedef unsigned v4u __attribute__((ext_vector_type(4)));
typedef float f32x4 __attribute__((ext_vector_type(4)));
typedef unsigned u32x2 __attribute__((ext_vector_type(2)));
#define LDS_WAIT() asm volatile("s_waitcnt lgkmcnt(0)" ::: "memory")
__device__ __forceinline__ unsigned pk2(float lo, float hi) { return (unsigned)f2a(lo) | ((unsigned)f2a(hi) << 16); }

__device__ __forceinline__ void wconv_item(const float* W, int ldw, act_t* WT, int K, int k0, int nsrc0, int ndst0, LAS float* scr, int lane, int nvalid = 32) {
    const int r8 = lane >> 3, c4 = (lane & 7) * 4;
    f32x4 v[8];
#pragma unroll
    for (int i = 0; i < 8; ++i) v[i] = c4 < nvalid ? *(const f32x4*)(W + (size_t)(k0 + 8 * i + r8) * ldw + nsrc0 + c4) : (f32x4){0.f, 0.f, 0.f, 0.f};
#pragma unroll
    for (int i = 0; i < 8; ++i) { LAS float* d = scr + (8 * i + r8) * 33 + c4; d[0] = v[i][0]; d[1] = v[i][1]; d[2] = v[i][2]; d[3] = v[i][3]; }
    LDS_WAIT(); asm volatile("" ::: "memory");
    const int c = lane & 7;
#pragma unroll
    for (int j = 0; j < 4; ++j) { const int n = (lane >> 3) + 8 * j; const LAS float* s = scr + (8 * c) * 33 + n;
        v4u o; o.x = pk2(s[0 * 33], s[1 * 33]); o.y = pk2(s[2 * 33], s[3 * 33]); o.z = pk2(s[4 * 33], s[5 * 33]); o.w = pk2(s[6 * 33], s[7 * 33]);
        *(v4u*)(WT + (size_t)(ndst0 + n) * K + k0 + 8 * c) = o; }
    LDS_WAIT(); asm volatile("" ::: "memory");
}
__device__ __forceinline__ int gu_row(int c, int up) { return (c >> 7) * 256 + (c & 127) + up * 128; }

__device__ __forceinline__ void ph_wconv(const P& p, int sel, unsigned char* lds, int gw, int ngw, int lane, int wave) {
    LAS float* scr = (LAS float*)lds + wave * (64 * 33 + 64);
    if (sel == 0) {
        constexpr int I_IN = 16 * (UNP / 32), I_OUT = 16 * 32, I_G = 16 * (DFF / 32), I_D = (DFF / 64) * 32;
        constexpr int NIT = 2 * I_IN + 2 * I_OUT + 2 * I_G + I_D;
        for (int it = gw; it < NIT; it += ngw) {
            int r = it;
            if (r < 2 * I_IN) { const int l = r / I_IN; r %= I_IN; const int kb = r / (UNP / 32), nb = r % (UNP / 32), nd = nb * 32, ns = nd < W_DT ? nd : (nd < UN ? nd + 8 : W_DT);
                wconv_item(p.w_in + (size_t)l * D * IN_DIM, IN_DIM, p.win_t + (size_t)l * UNP * D, D, kb * 64, ns, nd, scr, lane, nd < UN ? 32 : (nd == UN ? 8 : 0)); continue; } r -= 2 * I_IN;
            if (r < 2 * I_OUT) { const int l = r / I_OUT; r %= I_OUT; const int kb = r / 32, nb = r % 32;
                wconv_item(p.w_out + (size_t)l * D * D, D, p.wout_t + (size_t)l * D * D, D, kb * 64, nb * 32, nb * 32, scr, lane); continue; } r -= 2 * I_OUT;
            if (r < 2 * I_G) { const int up = r / I_G; r %= I_G; const int kb = r / (DFF / 32), nb = r % (DFF / 32);
                wconv_item(up ? p.ffn_wu : p.ffn_wg, DFF, p.wgu_t, D, kb * 64, nb * 32, gu_row(nb * 32, up), scr, lane); continue; } r -= 2 * I_G;
            { const int kb = r / 32, nb = r % 32; wconv_item(p.ffn_wd, D, p.wd_t, DFF, kb * 64, nb * 32, nb * 32, scr, lane); }
        }
    } else {
        constexpr int I_G = 16 * (DFFE / 32), I_D = (DFFE / 64) * 32;
        constexpr int NIT = NE * (2 * I_G + I_D);
        for (int it = gw; it < NIT; it += ngw) {
            const int e = it / (2 * I_G + I_D); int r = it % (2 * I_G + I_D);
            if (r < 2 * I_G) { const int up = r / I_G; r %= I_G; const int kb = r / (DFFE / 32), nb = r % (DFFE / 32);
                wconv_item((up ? p.ex_wu : p.ex_wg) + (size_t)e * D * DFFE, DFFE, p.egu_t + (size_t)e * 2 * DFFE * D, D, kb * 64, nb * 32, gu_row(nb * 32, up), scr, lane); continue; } r -= 2 * I_G;
            { const int kb = r / 32, nb = r % 32; wconv_item(p.ex_wd + (size_t)e * DFFE * D, D, p.ed_t + (size_t)e * D * DFFE, DFFE, kb * 64, nb * 32, nb * 32, scr, lane); }
        }
    }
}

__device__ __forceinline__ float wave_sum(float v) {
#pragma unroll
    for (int o = 1; o < 64; o <<= 1) v += __shfl_xor(v, o);
    return v;
}
__device__ __forceinline__ void fp_mod(const P& p, unsigned char* lds) {
    LAS float* red = (LAS float*)lds;
    const int tid = ltid(), wave_ = tid >> 6, lane_ = tid & 63, kq = lane_ >> 4, c4 = (lane_ & 15) * 4;
    for (int item = blockIdx.x; item < 2 * 96; item += gridDim.x) {
        const int l = item / 96, n0 = (item % 96) * 64;
        const float* w = p.w_ada + (size_t)l * D * 6 * D + n0 + c4;
        f32x4 a0 = {0.f, 0.f, 0.f, 0.f}, a1 = {0.f, 0.f, 0.f, 0.f};
#pragma unroll 8
        for (int i = 0; i < 32; ++i) { const int k = wave_ * 128 + i * 4 + kq; const f32x4 wv = *(const f32x4*)(w + (size_t)k * 6 * D); const float c0 = p.c[k], c1 = p.c[D + k]; a0 += wv * c0; a1 += wv * c1; }
#pragma unroll
        for (int j = 0; j < 4; ++j) { a0[j] += __shfl_xor(a0[j], 16); a0[j] += __shfl_xor(a0[j], 32); a1[j] += __shfl_xor(a1[j], 16); a1[j] += __shfl_xor(a1[j], 32); }
        if (kq == 0) { *(LAS f32x4*)(red + (wave_ * 2 + 0) * 64 + c4) = a0; *(LAS f32x4*)(red + (wave_ * 2 + 1) * 64 + c4) = a1; }
        __syncthreads();
        if (tid < 128) { const int b = tid >> 6, cc = tid & 63; float s = 0.f;
#pragma unroll
            for (int w8 = 0; w8 < 8; ++w8) s += red[(w8 * 2 + b) * 64 + cc];
            p.mod[((size_t)l * NB + b) * 6 * D + n0 + cc] = s + p.b_ada[l * 6 * D + n0 + cc]; }
        __syncthreads();
    }
}
__device__ __forceinline__ void fp_rotab(const P& p) {
    for (int it = blockIdx.x * 512 + ltid(); it < T * 32; it += gridDim.x * 512) { const int i = it & 31, t = it >> 5;
        const float inv = expf((-9.210340371976184f * (float)i) / 32.0f), ang = (float)p.pos[t] * inv;
        p.cs[(size_t)t * 64 + i] = cosf(ang); p.cs[(size_t)t * 64 + 32 + i] = sinf(ang); }
}
__device__ __forceinline__ void fp_modulate0(const P& p) {
    const size_t n4 = (size_t)T * D / 4;
    for (size_t i = (size_t)blockIdx.x * 512 + ltid(); i < n4; i += (size_t)gridDim.x * 512) {
        const size_t t = i / (D / 4); const int d = (int)(i % (D / 4)) * 4, b = (int)(t / L);
        const float* m = p.mod + (size_t)b * 6 * D;
        const f32x4 xv = *(const f32x4*)(p.x + i * 4), sh = *(const f32x4*)(m + d), sc = *(const f32x4*)(m + D + d);
        const f32x4 h = xv * (sc + 1.0f) + sh;
        u32x2 o; o.x = pk2(h[0], h[1]); o.y = pk2(h[2], h[3]); *(u32x2*)(p.hb + i * 4) = o;
    }
}
__device__ __forceinline__ void fp_scan(const P& p) {
    constexpr int NR = NB * 4 * 4096, NS = NB * 8 * 4096;
    for (int it = blockIdx.x * 512 + ltid(); it < NR + NS; it += gridDim.x * 512) {
        float* base; size_t stride; const float* cd = nullptr; float dec = 0.f;
        if (it < NR) { const int el = it % 4096, h = (it / 4096) % 4, b = it / (4096 * 4); base = p.st_ret + ((size_t)b * NCH * 4 + h) * 4096 + el; stride = (size_t)4 * 4096; dec = expf(loggamma(h) * (float)CH); }
        else { const int i2 = it - NR; const int el = i2 % 4096, hd = (i2 / 4096) % 8, b = i2 / (4096 * 8); base = p.st_ssd + ((size_t)b * NCH * 8 + hd) * 4096 + el; stride = (size_t)8 * 4096; cd = p.cdec + (size_t)b * NCH * 8 + hd; }
        float S = 0.f;
        for (int c0 = 0; c0 < NCH; c0 += 8) {
            float v[8], dd[8];
#pragma unroll
            for (int j = 0; j < 8; ++j) { v[j] = base[(size_t)(c0 + j) * stride]; dd[j] = cd ? cd[(size_t)(c0 + j) * 8] : dec; }
#pragma unroll
            for (int j = 0; j < 8; ++j) { base[(size_t)(c0 + j) * stride] = S; S = dd[j] * S + v[j]; }
        }
    }
}
template <int FSRC, bool HNEXT, bool ROUTE>
__device__ __forceinline__ void fp_ln(const P& p, int layer, int which, const float* xin, float* xout, int hl, int hsel, unsigned char* lds) {
    const int tid = ltid(), wave_ = __builtin_amdgcn_readfirstlane(tid >> 6), lane_ = tid & 63;
    LAS float* rw = (LAS float*)lds;
    LAS int* lcnt = (LAS int*)(lds + 32768); LAS int* lbase = lcnt + 8; LAS int* rexp = lcnt + 16; LAS int* rpos = rexp + 128;
    if constexpr (ROUTE) { for (int i = tid; i < D * NE / 4; i += 512) *(LAS f32x4*)(rw + i * 4) = *(const f32x4*)(p.router_w + i * 4); if (tid < 8) lcnt[tid] = 0; __syncthreads(); }
    const float* lg = p.ln_g + ((size_t)layer * 2 + which) * D; const float* lb = p.ln_b + ((size_t)layer * 2 + which) * D;
    constexpr int R = 2;
    const int nw = gridDim.x * 8;
    for (int row0 = blockIdx.x * 8 + wave_; row0 < T; row0 += R * nw) {
        f32x4 v[R][4]; float s[R], rs[R]; int bb[R];
#pragma unroll
        for (int r = 0; r < R; ++r) { const int row = row0 + r * nw; const int b = row / L; bb[r] = b; s[r] = 0.f;
            const float* gate = p.mod + ((size_t)layer * NB + b) * 6 * D + (which ? 5 : 2) * D;
            float w0 = 0.f, w1 = 0.f; size_t r0 = 0, r1 = 0;
            if constexpr (FSRC == 1) { const int e0 = p.top_e[row * 2], e1 = p.top_e[row * 2 + 1]; r0 = (size_t)moe_rb(p, e0) + p.top_p[row * 2]; r1 = (size_t)moe_rb(p, e1) + p.top_p[row * 2 + 1]; w0 = p.top_w[row * 2]; w1 = p.top_w[row * 2 + 1]; }
#pragma unroll
            for (int j = 0; j < 4; ++j) { const int idx = 4 * lane_ + 256 * j; const f32x4 xv = *(const f32x4*)(xin + (size_t)row * D + idx), gt = *(const f32x4*)(gate + idx); f32x4 fv;
                if constexpr (FSRC == 0) fv = *(const f32x4*)(p.gout + (size_t)row * D + idx);
                else { const u32x2 ya = *(const u32x2*)(p.ybuf + r0 * D + idx), yb = *(const u32x2*)(p.ybuf + r1 * D + idx);
                    fv[0] = w0 * __uint_as_float(ya.x << 16) + w1 * __uint_as_float(yb.x << 16); fv[1] = w0 * __uint_as_float(ya.x & 0xffff0000u) + w1 * __uint_as_float(yb.x & 0xffff0000u);
                    fv[2] = w0 * __uint_as_float(ya.y << 16) + w1 * __uint_as_float(yb.y << 16); fv[3] = w0 * __uint_as_float(ya.y & 0xffff0000u) + w1 * __uint_as_float(yb.y & 0xffff0000u); }
                v[r][j] = xv * ALPHA + (gt + 1.0f) * fv; s[r] += (v[r][j][0] + v[r][j][1]) + (v[r][j][2] + v[r][j][3]); } }
#pragma unroll
        for (int r = 0; r < R; ++r) { const float mean = wave_sum(s[r]) * (1.0f / D); float s2 = 0.f;
#pragma unroll
            for (int j = 0; j < 4; ++j) { v[r][j] = v[r][j] - mean; s2 += (v[r][j][0] * v[r][j][0] + v[r][j][1] * v[r][j][1]) + (v[r][j][2] * v[r][j][2] + v[r][j][3] * v[r][j][3]); }
            rs[r] = 1.0f / sqrtf(wave_sum(s2) * (1.0f / D) + LN_EPS); }
#pragma unroll
        for (int r = 0; r < R; ++r) { const int row = row0 + r * nw;
            const float* m = p.mod + ((size_t)(hl < 0 ? 0 : hl) * NB + bb[r]) * 6 * D + hsel * 3 * D;
            float lgt[NE];
#pragma unroll
            for (int e = 0; e < NE; ++e) lgt[e] = 0.f;
#pragma unroll
            for (int j = 0; j < 4; ++j) { const int idx = 4 * lane_ + 256 * j; const f32x4 o = v[r][j] * rs[r] * *(const f32x4*)(lg + idx) + *(const f32x4*)(lb + idx);
                *(f32x4*)(xout + (size_t)row * D + idx) = o;
                if constexpr (HNEXT || ROUTE) { const f32x4 h = o * (*(const f32x4*)(m + D + idx) + 1.0f) + *(const f32x4*)(m + idx);
                    if constexpr (HNEXT) { u32x2 hv; hv.x = pk2(h[0], h[1]); hv.y = pk2(h[2], h[3]); *(u32x2*)(p.hb + (size_t)row * D + idx) = hv; }
                    if constexpr (ROUTE) {
#pragma unroll
                        for (int cc = 0; cc < 4; ++cc) { const f32x4 wa = *(const LAS f32x4*)(rw + (idx + cc) * 8), wb = *(const LAS f32x4*)(rw + (idx + cc) * 8 + 4);
                            lgt[0] += h[cc] * wa[0]; lgt[1] += h[cc] * wa[1]; lgt[2] += h[cc] * wa[2]; lgt[3] += h[cc] * wa[3]; lgt[4] += h[cc] * wb[0]; lgt[5] += h[cc] * wb[1]; lgt[6] += h[cc] * wb[2]; lgt[7] += h[cc] * wb[3]; } } } }
            if constexpr (ROUTE) {
#pragma unroll
                for (int e = 0; e < NE; ++e) lgt[e] = wave_sum(lgt[e]) + p.router_b[e];
                float v1 = -3.0e38f, v2 = -3.0e38f; int i1 = 0, i2 = 0;
#pragma unroll
                for (int e = 0; e < NE; ++e) { const float vv = lgt[e]; if (vv > v1) { v2 = v1; i2 = i1; v1 = vv; i1 = e; } else if (vv > v2) { v2 = vv; i2 = e; } }
                if (lane_ == 0) { const float wt1 = 1.0f / (1.0f + expf(v2 - v1));
                    const int li = wave_ * 8 + (row - (int)blockIdx.x * 8 - wave_) / nw;
                    const int p1 = __hip_atomic_fetch_add(lcnt + i1, 1, __ATOMIC_RELAXED, __HIP_MEMORY_SCOPE_WORKGROUP), p2 = __hip_atomic_fetch_add(lcnt + i2, 1, __ATOMIC_RELAXED, __HIP_MEMORY_SCOPE_WORKGROUP);
                    rexp[li * 2] = i1; rexp[li * 2 + 1] = i2; rpos[li * 2] = p1; rpos[li * 2 + 1] = p2;
                    p.top_e[row * 2] = i1; p.top_e[row * 2 + 1] = i2; p.top_w[row * 2] = wt1; p.top_w[row * 2 + 1] = 1.0f - wt1; }
            }
        }
    }
    if constexpr (ROUTE) {
        __syncthreads();
        if (tid < 8) lbase[tid] = atomicAdd(p.cnt + tid, lcnt[tid]);
        __syncthreads();
        if (tid < 128) { const int li = tid >> 1, k = tid & 1, e = rexp[tid], pos = lbase[e] + rpos[tid]; const int row = (int)blockIdx.x * 8 + (li >> 3) + (li & 7) * nw;
            p.slot_tok[(size_t)e * T + pos] = row; p.top_p[row * 2 + k] = pos; }
        __syncthreads();
    }
}

typedef short mbf16x8 __attribute__((ext_vector_type(8)));
typedef unsigned mu32x4 __attribute__((ext_vector_type(4)));
__device__ __forceinline__ mbf16x8 ldfrag(const LAS act_t* base, int ld, int row, int k) { return *(const LAS mbf16x8*)(base + row * ld + k); }
#define MFMA16(a, b, c) __builtin_amdgcn_mfma_f32_16x16x32_bf16(a, b, c, 0, 0, 0)
__device__ __forceinline__ float bf_lo(unsigned w) { return __uint_as_float(w << 16); }
__device__ __forceinline__ float bf_hi(unsigned w) { return __uint_as_float(w & 0xffff0000u); }
__device__ __forceinline__ void unpack8(const mu32x4 w, float* f) { f[0] = bf_lo(w.x); f[1] = bf_hi(w.x); f[2] = bf_lo(w.y); f[3] = bf_hi(w.y); f[4] = bf_lo(w.z); f[5] = bf_hi(w.z); f[6] = bf_lo(w.w); f[7] = bf_hi(w.w); }
__device__ __forceinline__ mu32x4 pack8(const float* f) { mu32x4 w; w.x = pk2(f[0], f[1]); w.y = pk2(f[2], f[3]); w.z = pk2(f[4], f[5]); w.w = pk2(f[6], f[7]); return w; }
__device__ __forceinline__ float fsilu(float x) { return x / (1.0f + __expf(-x)); }
constexpr float LOG2E = 1.4426950408889634f;

__device__ __forceinline__ void mx_ret_state(const P& p, int bc, int h, unsigned char* lds) {
    LAS act_t* kT = (LAS act_t*)lds; LAS act_t* vT = kT + 64 * 136;
    const int tid = ltid(), lane_ = tid & 63, w = __builtin_amdgcn_readfirstlane(tid >> 6), fr = lane_ & 15, fq = lane_ >> 4;
    const size_t t0 = (size_t)bc * CH; const float l2g = loggamma(h) * LOG2E;
    { const int row = tid >> 2, c8 = (tid & 3) * 8; const size_t t = t0 + row;
      act_t* qp = p.u + t * UN + U_RQ + h * 64; act_t* kp = p.u + t * UN + U_RK + h * 64; const float* csr = p.cs + t * 64;
      float cs_[8], sn_[8]; *(f32x4*)cs_ = *(const f32x4*)(csr + c8); *(f32x4*)(cs_ + 4) = *(const f32x4*)(csr + c8 + 4); *(f32x4*)sn_ = *(const f32x4*)(csr + 32 + c8); *(f32x4*)(sn_ + 4) = *(const f32x4*)(csr + 36 + c8);
      float a[8], b[8], n1[8], n2[8];
      unpack8(*(const mu32x4*)(qp + c8), a); unpack8(*(const mu32x4*)(qp + 32 + c8), b);
#pragma unroll
      for (int x = 0; x < 8; ++x) { n1[x] = a[x] * cs_[x] - b[x] * sn_[x]; n2[x] = a[x] * sn_[x] + b[x] * cs_[x]; }
      *(mu32x4*)(qp + c8) = pack8(n1); *(mu32x4*)(qp + 32 + c8) = pack8(n2);
      unpack8(*(const mu32x4*)(kp + c8), a); unpack8(*(const mu32x4*)(kp + 32 + c8), b);
#pragma unroll
      for (int x = 0; x < 8; ++x) { n1[x] = (a[x] * cs_[x] - b[x] * sn_[x]) * 0.125f; n2[x] = (a[x] * sn_[x] + b[x] * cs_[x]) * 0.125f; }
      *(mu32x4*)(kp + c8) = pack8(n1); *(mu32x4*)(kp + 32 + c8) = pack8(n2);
      const float dk = __builtin_amdgcn_exp2f(l2g * (float)(CH - 1 - row));
#pragma unroll
      for (int x = 0; x < 8; ++x) { kT[(c8 + x) * 136 + row] = f2a(n1[x] * dk); kT[(32 + c8 + x) * 136 + row] = f2a(n2[x] * dk); }
    }
#pragma unroll
    for (int i = 0; i < 2; ++i) { const int id = tid + 512 * i, row = id >> 3, c8 = (id & 7) * 8; const mu32x4 vv = *(const mu32x4*)(p.u + (t0 + row) * UN + U_RV + h * 64 + c8);
        vT[(c8 + 0) * 136 + row] = (act_t)(vv.x & 0xffffu); vT[(c8 + 1) * 136 + row] = (act_t)(vv.x >> 16); vT[(c8 + 2) * 136 + row] = (act_t)(vv.y & 0xffffu); vT[(c8 + 3) * 136 + row] = (act_t)(vv.y >> 16);
        vT[(c8 + 4) * 136 + row] = (act_t)(vv.z & 0xffffu); vT[(c8 + 5) * 136 + row] = (act_t)(vv.z >> 16); vT[(c8 + 6) * 136 + row] = (act_t)(vv.w & 0xffffu); vT[(c8 + 7) * 136 + row] = (act_t)(vv.w >> 16); }
    __syncthreads();
    const int eb = w & 3, db0 = (w >> 2) * 2;
    f32x4 acc[2] = {{0.f, 0.f, 0.f, 0.f}, {0.f, 0.f, 0.f, 0.f}};
#pragma unroll
    for (int ks = 0; ks < 4; ++ks) { const mbf16x8 sv = ldfrag(vT, 136, 16 * eb + fr, 32 * ks + 8 * fq);
#pragma unroll
        for (int d2 = 0; d2 < 2; ++d2) acc[d2] = MFMA16(ldfrag(kT, 136, 16 * (db0 + d2) + fr, 32 * ks + 8 * fq), sv, acc[d2]); }
    float* st = p.st_ret + ((size_t)bc * 4 + h) * 4096;
#pragma unroll
    for (int d2 = 0; d2 < 2; ++d2) *(f32x4*)(st + (16 * eb + fr) * 64 + 16 * (db0 + d2) + 4 * fq) = acc[d2];
    __syncthreads();
}

__device__ __forceinline__ void mx_ssd_state(const P& p, int layer, int bc, int g, unsigned char* lds) {
    LAS act_t* xsT = (LAS act_t*)lds;
    LAS act_t* BT = xsT + 4 * 64 * 136;
    LAS float* dtw = (LAS float*)(BT + 64 * 136);
    const int tid = ltid(), lane_ = tid & 63, w = __builtin_amdgcn_readfirstlane(tid >> 6), fr = lane_ & 15, fq = lane_ >> 4;
    const size_t t0 = (size_t)bc * CH; const int n = bc % NCH;
    if (w < 4) {
        const int hd = 4 * g + w; const float bias = p.dt_bias[layer * 8 + hd], A = -expf(p.a_log[layer * 8 + hd]);
        const size_t ta = t0 + 2 * lane_;
        const float d0 = softplusf(p.dtraw[ta * 8 + hd] + bias), d1 = softplusf(p.dtraw[(ta + 1) * 8 + hd] + bias);
        const float a0 = A * d0, a1 = A * d1; float inc = a0 + a1;
#pragma unroll
        for (int o = 1; o < 64; o <<= 1) { const float v = __shfl_up(inc, o); if (lane_ >= o) inc += v; }
        const float alast = __shfl(inc, 63), c1 = inc, c0 = inc - a1;
        p.dt[ta * 8 + hd] = d0; p.dt[(ta + 1) * 8 + hd] = d1; p.acs[ta * 8 + hd] = c0; p.acs[(ta + 1) * 8 + hd] = c1;
        dtw[w * 128 + 2 * lane_] = d0 * expf(alast - c0); dtw[w * 128 + 2 * lane_ + 1] = d1 * expf(alast - c1);
        if (lane_ == 0) p.cdec[(size_t)bc * 8 + hd] = expf(alast);
    }
    __syncthreads();
    if (tid < 384) {
        const int cg = tid % 48, rs = tid / 48, l0 = rs * 16;
        const int xc = cg < 32 ? 256 * g + cg * 8 : (cg < 40 ? 512 + 64 * g + (cg - 32) * 8 : 640 + 64 * g + (cg - 40) * 8);
        float cw[4][8], cbias[8];
#pragma unroll
        for (int k = 0; k < 4; ++k) { *(f32x4*)cw[k] = *(const f32x4*)(p.conv_w + ((size_t)layer * 4 + k) * XBC + xc); *(f32x4*)(cw[k] + 4) = *(const f32x4*)(p.conv_w + ((size_t)layer * 4 + k) * XBC + xc + 4); }
        *(f32x4*)cbias = *(const f32x4*)(p.conv_b + layer * XBC + xc); *(f32x4*)(cbias + 4) = *(const f32x4*)(p.conv_b + layer * XBC + xc + 4);
        float x0[8], x1[8], x2[8], x3[8];
        const act_t* src = p.u + t0 * UN + U_XS + xc;
        const bool first = (n == 0 && rs == 0);
        if (first) {
#pragma unroll
            for (int x = 0; x < 8; ++x) { x0[x] = 0.f; x1[x] = 0.f; x2[x] = 0.f; } }
        else { unpack8(*(const mu32x4*)(src + (ptrdiff_t)(l0 - 3) * UN), x0); unpack8(*(const mu32x4*)(src + (ptrdiff_t)(l0 - 2) * UN), x1); unpack8(*(const mu32x4*)(src + (ptrdiff_t)(l0 - 1) * UN), x2); }
#pragma unroll 4
        for (int r = 0; r < 16; ++r) { const int l = l0 + r;
            unpack8(*(const mu32x4*)(src + (size_t)l * UN), x3);
            float y[8];
#pragma unroll
            for (int x = 0; x < 8; ++x) { const float a = cbias[x] + x0[x] * cw[0][x] + x1[x] * cw[1][x] + x2[x] * cw[2][x] + x3[x] * cw[3][x]; y[x] = fsilu(a); x0[x] = x1[x]; x1[x] = x2[x]; x2[x] = x3[x]; }
            *(mu32x4*)(p.xbc + (t0 + l) * XBC + xc) = pack8(y);
            if (cg < 32) { const int hh = cg >> 3, p0 = (cg & 7) * 8; const float sc = dtw[hh * 128 + l];
#pragma unroll
                for (int x = 0; x < 8; ++x) xsT[(hh * 64 + p0 + x) * 136 + l] = f2a(y[x] * sc); }
            else if (cg < 40) { const int n0 = (cg - 32) * 8;
#pragma unroll
                for (int x = 0; x < 8; ++x) BT[(n0 + x) * 136 + l] = f2a(y[x]); }
        }
    }
    __syncthreads();
    const int pb = w & 3, nb0 = (w >> 2) * 2;
#pragma unroll
    for (int hh = 0; hh < 4; ++hh) {
        f32x4 acc[2] = {{0.f, 0.f, 0.f, 0.f}, {0.f, 0.f, 0.f, 0.f}};
#pragma unroll
        for (int ks = 0; ks < 4; ++ks) { const mbf16x8 sx = ldfrag(xsT + hh * 64 * 136, 136, 16 * pb + fr, 32 * ks + 8 * fq);
#pragma unroll
            for (int n2 = 0; n2 < 2; ++n2) acc[n2] = MFMA16(ldfrag(BT, 136, 16 * (nb0 + n2) + fr, 32 * ks + 8 * fq), sx, acc[n2]); }
        float* st = p.st_ssd + ((size_t)bc * 8 + 4 * g + hh) * 4096;
#pragma unroll
        for (int n2 = 0; n2 < 2; ++n2) *(f32x4*)(st + (16 * pb + fr) * 64 + 16 * (nb0 + n2) + 4 * fq) = acc[n2];
    }
    __syncthreads();
}

__device__ __forceinline__ void mx_ret_out(const P& p, int bc, int h, unsigned char* lds) {
    LAS act_t* qs = (LAS act_t*)lds;
    LAS act_t* ks_ = qs + 128 * 72;
    LAS act_t* vT = ks_ + 128 * 72;
    LAS act_t* pT = vT + 64 * 136;
    LAS act_t* Pw = pT + 64 * 72;
    const int tid = ltid(), lane_ = tid & 63, w = __builtin_amdgcn_readfirstlane(tid >> 6), fr = lane_ & 15, fq = lane_ >> 4;
    const size_t t0 = (size_t)bc * CH; const float l2g = loggamma(h) * LOG2E;
#pragma unroll
    for (int i = 0; i < 2; ++i) { const int id = tid + 512 * i, row = id >> 3, c8 = (id & 7) * 8; const act_t* ur = p.u + (t0 + row) * UN + h * 64 + c8;
        *(LAS mu32x4*)(qs + row * 72 + c8) = *(const mu32x4*)(ur + U_RQ); *(LAS mu32x4*)(ks_ + row * 72 + c8) = *(const mu32x4*)(ur + U_RK);
        const mu32x4 vv = *(const mu32x4*)(ur + U_RV);
        vT[(c8 + 0) * 136 + row] = (act_t)(vv.x & 0xffffu); vT[(c8 + 1) * 136 + row] = (act_t)(vv.x >> 16); vT[(c8 + 2) * 136 + row] = (act_t)(vv.y & 0xffffu); vT[(c8 + 3) * 136 + row] = (act_t)(vv.y >> 16);
        vT[(c8 + 4) * 136 + row] = (act_t)(vv.z & 0xffffu); vT[(c8 + 5) * 136 + row] = (act_t)(vv.z >> 16); vT[(c8 + 6) * 136 + row] = (act_t)(vv.w & 0xffffu); vT[(c8 + 7) * 136 + row] = (act_t)(vv.w >> 16); }
    { const int e = tid >> 3, d8 = (tid & 7) * 8; const float* sp = p.st_ret + ((size_t)bc * 4 + h) * 4096 + e * 64 + d8; float f[8]; *(f32x4*)f = *(const f32x4*)sp; *(f32x4*)(f + 4) = *(const f32x4*)(sp + 4);
      *(LAS mu32x4*)(pT + e * 72 + d8) = pack8(f); }
    __syncthreads();
    const int i0 = 16 * w, nbmax = w | 1; LAS act_t* Pm = Pw + w * 16 * 136;
    const mbf16x8 q0 = ldfrag(qs, 72, i0 + fr, 8 * fq), q1 = ldfrag(qs, 72, i0 + fr, 32 + 8 * fq);
    for (int nb = 0; nb <= nbmax; ++nb) {
        f32x4 s = {0.f, 0.f, 0.f, 0.f};
        s = MFMA16(ldfrag(ks_, 72, 16 * nb + fr, 8 * fq), q0, s); s = MFMA16(ldfrag(ks_, 72, 16 * nb + fr, 32 + 8 * fq), q1, s);
        const int i = i0 + fr, j0 = 16 * nb + 4 * fq; float pv[4];
#pragma unroll
        for (int r = 0; r < 4; ++r) { const int j = j0 + r; pv[r] = j <= i ? s[r] * __builtin_amdgcn_exp2f(l2g * (float)(i - j)) : 0.f; }
        u32x2 pk; pk.x = pk2(pv[0], pv[1]); pk.y = pk2(pv[2], pv[3]); *(LAS u32x2*)(Pm + fr * 136 + j0) = pk;
    }
    f32x4 o2[4], o3[4];
#pragma unroll
    for (int eb = 0; eb < 4; ++eb) { o2[eb] = (f32x4){0.f, 0.f, 0.f, 0.f}; o3[eb] = (f32x4){0.f, 0.f, 0.f, 0.f}; }
    const int ksmax = (nbmax + 1) >> 1;
    for (int ks = 0; ks < ksmax; ++ks) { const mbf16x8 pf = ldfrag(Pm, 136, fr, 32 * ks + 8 * fq);
#pragma unroll
        for (int eb = 0; eb < 4; ++eb) o2[eb] = MFMA16(ldfrag(vT, 136, 16 * eb + fr, 32 * ks + 8 * fq), pf, o2[eb]); }
#pragma unroll
    for (int eb = 0; eb < 4; ++eb) { o3[eb] = MFMA16(ldfrag(pT, 72, 16 * eb + fr, 8 * fq), q0, o3[eb]); o3[eb] = MFMA16(ldfrag(pT, 72, 16 * eb + fr, 32 + 8 * fq), q1, o3[eb]); }
    const float dq = __builtin_amdgcn_exp2f(l2g * (float)(i0 + fr + 1)); float sm = 0.f;
#pragma unroll
    for (int eb = 0; eb < 4; ++eb) { o2[eb] = o2[eb] + o3[eb] * dq; sm += (o2[eb][0] + o2[eb][1]) + (o2[eb][2] + o2[eb][3]); }
    sm += __shfl_xor(sm, 16); sm += __shfl_xor(sm, 32); const float mu = sm * (1.0f / 64.0f); float sq = 0.f;
#pragma unroll
    for (int eb = 0; eb < 4; ++eb) { o2[eb] = o2[eb] - mu; sq += (o2[eb][0] * o2[eb][0] + o2[eb][1] * o2[eb][1]) + (o2[eb][2] * o2[eb][2] + o2[eb][3] * o2[eb][3]); }
    sq += __shfl_xor(sq, 16); sq += __shfl_xor(sq, 32); const float rs = 1.0f / sqrtf(sq * (1.0f / 64.0f) + LN_EPS);
    const size_t t = t0 + i0 + fr;
#pragma unroll
    for (int eb = 0; eb < 4; ++eb) { const int e = h * 64 + 16 * eb + 4 * fq; const u32x2 gv = *(const u32x2*)(p.u + t * UN + U_RG + e);
        u32x2 ov; ov.x = pk2(fsilu(bf_lo(gv.x)) * o2[eb][0] * rs, fsilu(bf_hi(gv.x)) * o2[eb][1] * rs); ov.y = pk2(fsilu(bf_lo(gv.y)) * o2[eb][2] * rs, fsilu(bf_hi(gv.y)) * o2[eb][3] * rs);
        *(u32x2*)(p.ymix + t * D + e) = ov; }
    __syncthreads();
}

__device__ __forceinline__ void mx_ssd_out(const P& p, int layer, int bc, int g, unsigned char* lds) {
    LAS act_t* Cm = (LAS act_t*)lds;
    LAS act_t* Bm = Cm + 128 * 72;
    LAS act_t* xsT = Bm + 128 * 72;
    LAS act_t* pv_ = xsT + 64 * 136;
    LAS act_t* Pw = pv_ + 64 * 72;
    LAS float* tab = (LAS float*)(Pw + 8 * 16 * 136);
    const int tid = ltid(), lane_ = tid & 63, w = __builtin_amdgcn_readfirstlane(tid >> 6), fr = lane_ & 15, fq = lane_ >> 4;
    const size_t t0 = (size_t)bc * CH;
#pragma unroll
    for (int i = 0; i < 2; ++i) { const int id = tid + 512 * i, row = id >> 3, c8 = (id & 7) * 8; const act_t* xr = p.xbc + (t0 + row) * XBC + 64 * g + c8;
        *(LAS mu32x4*)(Cm + row * 72 + c8) = *(const mu32x4*)(xr + 640); *(LAS mu32x4*)(Bm + row * 72 + c8) = *(const mu32x4*)(xr + 512); }
    { const int hh = tid >> 7, l = tid & 127; tab[hh * 128 + l] = p.acs[(t0 + l) * 8 + 4 * g + hh]; tab[512 + hh * 128 + l] = p.dt[(t0 + l) * 8 + 4 * g + hh]; }
    __syncthreads();
    const int i0 = 16 * w, nbmax = w | 1, ksmax = (nbmax + 1) >> 1; LAS act_t* Pm = Pw + w * 16 * 136;
    const mbf16x8 c0 = ldfrag(Cm, 72, i0 + fr, 8 * fq), c1 = ldfrag(Cm, 72, i0 + fr, 32 + 8 * fq);
    f32x4 cb[8];
#pragma unroll
    for (int nb = 0; nb < 8; ++nb) { cb[nb] = (f32x4){0.f, 0.f, 0.f, 0.f};
        if (nb <= nbmax) { cb[nb] = MFMA16(ldfrag(Bm, 72, 16 * nb + fr, 8 * fq), c0, cb[nb]); cb[nb] = MFMA16(ldfrag(Bm, 72, 16 * nb + fr, 32 + 8 * fq), c1, cb[nb]); } }
    float ss = 0.f; const size_t t = t0 + i0 + fr;
#pragma unroll
    for (int hh = 0; hh < 4; ++hh) {
        const int hd = 4 * g + hh;
        __syncthreads();
#pragma unroll
        for (int i = 0; i < 2; ++i) { const int id = tid + 512 * i, row = id >> 3, c8 = (id & 7) * 8; const mu32x4 vv = *(const mu32x4*)(p.xbc + (t0 + row) * XBC + hd * 64 + c8);
            xsT[(c8 + 0) * 136 + row] = (act_t)(vv.x & 0xffffu); xsT[(c8 + 1) * 136 + row] = (act_t)(vv.x >> 16); xsT[(c8 + 2) * 136 + row] = (act_t)(vv.y & 0xffffu); xsT[(c8 + 3) * 136 + row] = (act_t)(vv.y >> 16);
            xsT[(c8 + 4) * 136 + row] = (act_t)(vv.z & 0xffffu); xsT[(c8 + 5) * 136 + row] = (act_t)(vv.z >> 16); xsT[(c8 + 6) * 136 + row] = (act_t)(vv.w & 0xffffu); xsT[(c8 + 7) * 136 + row] = (act_t)(vv.w >> 16); }
        { const int pp = tid >> 3, n8 = (tid & 7) * 8; const float* sp = p.st_ssd + ((size_t)bc * 8 + hd) * 4096 + pp * 64 + n8; float f[8]; *(f32x4*)f = *(const f32x4*)sp; *(f32x4*)(f + 4) = *(const f32x4*)(sp + 4);
          *(LAS mu32x4*)(pv_ + pp * 72 + n8) = pack8(f); }
        __syncthreads();
        const float al = tab[hh * 128 + i0 + fr];
#pragma unroll
        for (int nb = 0; nb < 8; ++nb) if (nb <= nbmax) {
            const int i = i0 + fr, j0 = 16 * nb + 4 * fq; const f32x4 as = *(const LAS f32x4*)(tab + hh * 128 + j0), ds = *(const LAS f32x4*)(tab + 512 + hh * 128 + j0); float pvv[4];
#pragma unroll
            for (int r = 0; r < 4; ++r) pvv[r] = (j0 + r) <= i ? cb[nb][r] * __expf(al - as[r]) * ds[r] : 0.f;
            u32x2 pk; pk.x = pk2(pvv[0], pvv[1]); pk.y = pk2(pvv[2], pvv[3]); *(LAS u32x2*)(Pm + fr * 136 + j0) = pk; }
        f32x4 y2[4], y3[4];
#pragma unroll
        for (int pb = 0; pb < 4; ++pb) { y2[pb] = (f32x4){0.f, 0.f, 0.f, 0.f}; y3[pb] = (f32x4){0.f, 0.f, 0.f, 0.f}; }
        for (int ks = 0; ks < ksmax; ++ks) { const mbf16x8 pf = ldfrag(Pm, 136, fr, 32 * ks + 8 * fq);
#pragma unroll
            for (int pb = 0; pb < 4; ++pb) y2[pb] = MFMA16(ldfrag(xsT, 136, 16 * pb + fr, 32 * ks + 8 * fq), pf, y2[pb]); }
#pragma unroll
        for (int pb = 0; pb < 4; ++pb) { y3[pb] = MFMA16(ldfrag(pv_, 72, 16 * pb + fr, 8 * fq), c0, y3[pb]); y3[pb] = MFMA16(ldfrag(pv_, 72, 16 * pb + fr, 32 + 8 * fq), c1, y3[pb]); }
        const float eal = __expf(al), dsk = p.d_skip[layer * 8 + hd];
#pragma unroll
        for (int pb = 0; pb < 4; ++pb) { const int pc = 16 * pb + 4 * fq; const u32x2 zv = *(const u32x2*)(p.u + t * UN + U_SZ + hd * 64 + pc); const u32x2 xv = *(const u32x2*)(p.xbc + t * XBC + hd * 64 + pc);
            f32x4 y = y2[pb] + y3[pb] * eal;
            y[0] = (y[0] + bf_lo(xv.x) * dsk) * fsilu(bf_lo(zv.x)); y[1] = (y[1] + bf_hi(xv.x) * dsk) * fsilu(bf_hi(zv.x)); y[2] = (y[2] + bf_lo(xv.y) * dsk) * fsilu(bf_lo(zv.y)); y[3] = (y[3] + bf_hi(xv.y) * dsk) * fsilu(bf_hi(zv.y));
            ss += (y[0] * y[0] + y[1] * y[1]) + (y[2] * y[2] + y[3] * y[3]);
            u32x2 ov; ov.x = pk2(y[0], y[1]); ov.y = pk2(y[2], y[3]); *(u32x2*)(p.ymix + t * D + 256 + hd * 64 + pc) = ov; }
    }
    ss += __shfl_xor(ss, 16); ss += __shfl_xor(ss, 32); const float rs = 1.0f / sqrtf(ss * (1.0f / 256.0f) + LN_EPS);
#pragma unroll
    for (int hh = 0; hh < 4; ++hh)
#pragma unroll
        for (int pb = 0; pb < 4; ++pb) { const int ch = (4 * g + hh) * 64 + 16 * pb + 4 * fq; const f32x4 nw = *(const f32x4*)(p.ssd_norm_w + layer * 512 + ch);
            const u32x2 yv = *(const u32x2*)(p.ymix + t * D + 256 + ch);
            u32x2 ov; ov.x = pk2(bf_lo(yv.x) * rs * nw[0], bf_hi(yv.x) * rs * nw[1]); ov.y = pk2(bf_lo(yv.y) * rs * nw[2], bf_hi(yv.y) * rs * nw[3]); *(u32x2*)(p.ymix + t * D + 256 + ch) = ov; }
    __syncthreads();
}

__device__ __forceinline__ void mx_swa(const P& p, int layer, int bc, int kvh, unsigned char* lds) {
    LAS act_t* Kw = (LAS act_t*)lds;
    LAS act_t* VT = Kw + 256 * 72;
    LAS act_t* Pw = VT + 64 * 280;
    LAS float* bt = (LAS float*)(Pw + 8 * 16 * 168);
    const int tid = ltid(), lane_ = tid & 63, w = __builtin_amdgcn_readfirstlane(tid >> 6), fr = lane_ & 15, fq = lane_ >> 4;
    const size_t t0 = (size_t)bc * CH; const int nb_ = bc % NCH;
#pragma unroll
    for (int i = 0; i < 4; ++i) { const int id = tid + 512 * i, row = id >> 3, c8 = (id & 7) * 8;
        mu32x4 kk = {0u, 0u, 0u, 0u}, vv = {0u, 0u, 0u, 0u};
        if (nb_ > 0 || row >= 128) { const act_t* ur = p.u + (size_t)((ptrdiff_t)t0 - 128 + row) * UN + kvh * 64 + c8; kk = *(const mu32x4*)(ur + U_AK); vv = *(const mu32x4*)(ur + U_AV); }
        *(LAS mu32x4*)(Kw + row * 72 + c8) = kk;
        VT[(c8 + 0) * 280 + row] = (act_t)(vv.x & 0xffffu); VT[(c8 + 1) * 280 + row] = (act_t)(vv.x >> 16); VT[(c8 + 2) * 280 + row] = (act_t)(vv.y & 0xffffu); VT[(c8 + 3) * 280 + row] = (act_t)(vv.y >> 16);
        VT[(c8 + 4) * 280 + row] = (act_t)(vv.z & 0xffffu); VT[(c8 + 5) * 280 + row] = (act_t)(vv.z >> 16); VT[(c8 + 6) * 280 + row] = (act_t)(vv.w & 0xffffu); VT[(c8 + 7) * 280 + row] = (act_t)(vv.w >> 16); }
    for (int i = tid; i < 64 * 24; i += 512) VT[(i / 24) * 280 + 256 + (i % 24)] = (act_t)0;
    if (tid < 256) { const int hq2 = tid >> 7, dist = tid & 127; bt[tid] = p.rel_bias[T5B[dist] * 4 + 2 * kvh + hq2]; }
    __syncthreads();
    const int i0 = 16 * w; LAS act_t* Pm = Pw + w * 16 * 168;
    const size_t t = t0 + i0 + fr;
#pragma unroll 1
    for (int hq2 = 0; hq2 < 2; ++hq2) {
        const int hq = 2 * kvh + hq2; const float sink = p.sinks[layer * 4 + hq];
        const act_t* qrow = p.u + t * UN + U_AQ + hq * 64;
        const mbf16x8 q0 = *(const mbf16x8*)(qrow + 8 * fq), q1 = *(const mbf16x8*)(qrow + 32 + 8 * fq);
        f32x4 s[9]; float mx = -3.0e38f;
#pragma unroll
        for (int jb = 0; jb < 9; ++jb) { s[jb] = (f32x4){0.f, 0.f, 0.f, 0.f};
            s[jb] = MFMA16(ldfrag(Kw, 72, 16 * (w + jb) + fr, 8 * fq), q0, s[jb]); s[jb] = MFMA16(ldfrag(Kw, 72, 16 * (w + jb) + fr, 32 + 8 * fq), q1, s[jb]);
#pragma unroll
            for (int r = 0; r < 4; ++r) { const int jw = 16 * (w + jb) + 4 * fq + r, dist = 128 + i0 + fr - jw; const bool ok = dist >= 0 && dist < 128 && (nb_ > 0 || jw >= 128);
                const float lg = ok ? s[jb][r] * 0.125f + bt[hq2 * 128 + (dist & 127)] : -3.0e38f; s[jb][r] = lg; mx = fmaxf(mx, lg); } }
        mx = fmaxf(mx, __shfl_xor(mx, 16)); mx = fmaxf(mx, __shfl_xor(mx, 32)); mx = fmaxf(mx, sink);
        float den = 0.f;
#pragma unroll
        for (int jb = 0; jb < 9; ++jb)
#pragma unroll
            for (int r = 0; r < 4; ++r) { const float pr = s[jb][r] > -1.0e38f ? __expf(s[jb][r] - mx) : 0.f; s[jb][r] = pr; den += pr; }
        den += __shfl_xor(den, 16); den += __shfl_xor(den, 32); den += __expf(sink - mx);
        const float inv = 1.0f / den;
#pragma unroll
        for (int jb = 0; jb < 10; ++jb) { u32x2 pk = {0u, 0u}; if (jb < 9) { pk.x = pk2(s[jb < 9 ? jb : 0][0] * inv, s[jb < 9 ? jb : 0][1] * inv); pk.y = pk2(s[jb < 9 ? jb : 0][2] * inv, s[jb < 9 ? jb : 0][3] * inv); }
            *(LAS u32x2*)(Pm + fr * 168 + 16 * jb + 4 * fq) = pk; }
        f32x4 o[4];
#pragma unroll
        for (int eb = 0; eb < 4; ++eb) o[eb] = (f32x4){0.f, 0.f, 0.f, 0.f};
#pragma unroll
        for (int ks = 0; ks < 5; ++ks) { const mbf16x8 pf = ldfrag(Pm, 168, fr, 32 * ks + 8 * fq);
#pragma unroll
            for (int eb = 0; eb < 4; ++eb) o[eb] = MFMA16(ldfrag(VT, 280, 16 * eb + fr, 16 * w + 32 * ks + 8 * fq), pf, o[eb]); }
#pragma unroll
        for (int eb = 0; eb < 4; ++eb) { u32x2 ov; ov.x = pk2(o[eb][0], o[eb][1]); ov.y = pk2(o[eb][2], o[eb][3]); *(u32x2*)(p.ymix + t * D + 768 + hq * 64 + 16 * eb + 4 * fq) = ov; }
    }
    __syncthreads();
}

__device__ __forceinline__ void fp_mix1(const P& p, int layer, unsigned char* lds) {
    for (int uu = blockIdx.x; uu < 2 * NB * NCH; uu += gridDim.x) { const int bc = uu >> 1, hf = uu & 1;
        mx_ssd_state(p, layer, bc, hf, lds); mx_ret_state(p, bc, 2 * hf, lds); mx_ret_state(p, bc, 2 * hf + 1, lds); }
}
__device__ __forceinline__ void fp_mix3(const P& p, int layer, unsigned char* lds) {
    for (int uu = blockIdx.x; uu < 2 * NB * NCH; uu += gridDim.x) { const int bc = uu >> 1, hf = uu & 1;
        mx_ssd_out(p, layer, bc, hf, lds); mx_swa(p, layer, bc, hf, lds); mx_ret_out(p, bc, 2 * hf, lds); mx_ret_out(p, bc, 2 * hf + 1, lds); }
}

__device__ __forceinline__ void fp_inproj(const P& p, int layer, unsigned char* lds) {
    pg8::StaticOrder S; S.init(p.hb, p.win_t + (size_t)layer * UNP * D, T, UNP, D, gridDim.x, blockIdx.x);
    pg8::EpiInproj E{p.u, p.dtraw};
    pg8::gemm_phase<pg8::EpiInproj, pg8::StaticOrder, true, false>((LAS unsigned char*)lds, D, S, E);
}
__device__ __forceinline__ void fp_outproj(const P& p, int layer, unsigned char* lds) {
    pg8::StaticOrder S; S.init(p.ymix, p.wout_t + (size_t)layer * D * D, T, D, D, gridDim.x, blockIdx.x);
    pg8::EpiF32 E{p.gout, D};
    pg8::gemm_phase<pg8::EpiF32, pg8::StaticOrder, false, false>((LAS unsigned char*)lds, D, S, E);
}
__device__ __forceinline__ void fp_ffn_gu(const P& p, unsigned char* lds) {
    pg8::StaticOrder S; S.init(p.hb, p.wgu_t, T, 2 * DFF, D, gridDim.x, blockIdx.x);
    pg8::EpiSwiglu E{p.act, DFF};
    pg8::gemm_phase<pg8::EpiSwiglu, pg8::StaticOrder, true, false>((LAS unsigned char*)lds, D, S, E);
}
__device__ __forceinline__ void fp_ffn_dn(const P& p, unsigned char* lds) {
    pg8::StaticOrder S; S.init(p.act, p.wd_t, T, D, DFF, gridDim.x, blockIdx.x);
    pg8::EpiF32 E{p.gout, D};
    pg8::gemm_phase<pg8::EpiF32, pg8::StaticOrder, false, false>((LAS unsigned char*)lds, DFF, S, E);
}
__device__ __forceinline__ void moe_table(const P& p, unsigned char* lds) {
    LAS int* tab = (LAS int*)(lds + LDS_MOE_OFF);
    if (ltid() == 0) { int acc = 0;
#pragma unroll
        for (int e = 0; e < NE; ++e) { const int c = p.cnt[e]; tab[e] = acc; tab[16 + e] = c; acc += (c + 255) / 256; }
        tab[8] = acc; }
    __syncthreads();
}
__device__ __forceinline__ void fp_moe(const P& p, int which, int pass, unsigned char* lds) {
    moe_table(p, lds);
    const LAS int* tab = (const LAS int*)(lds + LDS_MOE_OFF);
    int nM = tab[8] - pass * CAPT; nM = nM < 0 ? 0 : (nM > CAPT ? CAPT : nM);
    pg8::MoeOrder S; S.tab = tab; S.slot_tok = p.slot_tok; S.G = gridDim.x; S.c = blockIdx.x; S.rt0 = pass * CAPT; S.which = which; S.nM = nM;
    if (which == 0) { S.A = (const char*)p.hb; S.Bt = (const char*)p.egu_t; S.tstepA = 0; S.tstepB = (size_t)256 * D * 2; S.estepB = (size_t)2 * DFFE * D * 2; S.nN = 2 * DFFE / 256;
        pg8::EpiSwiglu E{p.act, DFFE};
        pg8::gemm_phase<pg8::EpiSwiglu, pg8::MoeOrder, true, true>((LAS unsigned char*)lds, D, S, E);
    } else { S.A = (const char*)p.act; S.Bt = (const char*)p.ed_t; S.tstepA = (size_t)256 * DFFE * 2; S.tstepB = (size_t)256 * DFFE * 2; S.estepB = (size_t)D * DFFE * 2; S.nN = D / 256;
        pg8::EpiBf16 E{p.ybuf, D};
        pg8::gemm_phase<pg8::EpiBf16, pg8::MoeOrder, true, false>((LAS unsigned char*)lds, DFFE, S, E);
    }
}

__global__ void __launch_bounds__(512, 2) mk_fwd(P p) {
    extern __shared__ __attribute__((aligned(16))) unsigned char lds[];
    for (int w = threadIdx.x; w < (LDS_BYTES - LDS_CTL_OFF) / 4; w += 512) ((LAS unsigned*)(lds + LDS_CTL_OFF))[w] = 0u;
    __syncthreads();
    XcdBarrier bar = xcd_barrier_post(p.bar, (volatile LAS unsigned*)(lds + LDS_BAR_OFF));
    float* sm = (float*)lds;
    const int bid = blockIdx.x, nblk = gridDim.x;
#define gtid ((long)(blockIdx.x * 512 + ltid()))
#define gsz ((long)(gridDim.x * 512))
#define PH(id, layer) run_phase<id>(p, layer, gtid, gsz, bid, nblk, sm)
#define BAR() xcd_barrier(bar)
#define lane ((int)(ltid() & 63))
#define wave (__builtin_amdgcn_readfirstlane((int)(ltid() >> 6)))
#define gw ((int)blockIdx.x * 8 + wave)
#define ngw ((int)gridDim.x * 8)
#define TM(idx, ...) do { if constexpr (((PROBE_MASK) >> (idx)) & 1ull) { const unsigned long long t0_ = __builtin_amdgcn_s_memrealtime(); __VA_ARGS__; const unsigned long long t1_ = __builtin_amdgcn_s_memrealtime(); \
        while (__builtin_amdgcn_s_memrealtime() < t1_ + (t1_ - t0_)) __builtin_amdgcn_s_sleep(8); } else { __VA_ARGS__; } } while (0)
    TM(0, fp_mod(p, lds); fp_rotab(p); ph_wconv(p, 0, lds, gw, ngw, lane, wave); ph_wconv(p, 1, lds, gw, ngw, lane, wave)); BAR();
    TM(1, fp_modulate0(p)); BAR();
#define MIXER(layer) \
        TM(2 + 9 * layer, fp_inproj(p, layer, lds)); BAR(); \
        TM(3 + 9 * layer, fp_mix1(p, layer, lds)); BAR(); \
        TM(4 + 9 * layer, fp_scan(p)); BAR(); \
        TM(5 + 9 * layer, fp_mix3(p, layer, lds)); BAR(); \
        TM(6 + 9 * layer, fp_outproj(p, layer, lds)); BAR();
    MIXER(0)
    TM(7, fp_ln<0, true, false>(p, 0, 0, p.x, p.out, 0, 1, lds)); BAR();
    TM(8, fp_ffn_gu(p, lds)); BAR();
    TM(9, fp_ffn_dn(p, lds)); BAR();
    TM(10, fp_ln<0, true, false>(p, 0, 1, p.out, p.xb, 1, 0, lds)); BAR();
    MIXER(1)
    TM(16, fp_ln<0, true, true>(p, 1, 0, p.xb, p.out, 1, 1, lds)); BAR();
    TM(17, fp_moe(p, 0, 0, lds)); BAR();
    TM(18, fp_moe(p, 1, 0, lds)); BAR();
    TM(19, fp_moe(p, 0, 1, lds)); BAR();
    TM(20, fp_moe(p, 1, 1, lds)); BAR();
    TM(21, fp_ln<1, false, false>(p, 1, 1, p.out, p.out, -1, 0, lds));
#undef TM
#undef MIXER
#undef gtid
#undef gsz
#undef lane
#undef wave
#undef gw
#undef ngw
#undef PH
#undef BAR
}

extern "C" void kernel_launch(void* const* d_in, const int* in_sizes, int n_in, void* d_out, int out_size, void* d_ws, size_t ws_size, hipStream_t stream) {
    static WsMap m = make_map();
    if (n_in != 25 || out_size != T * D || ws_size < m.end) { fprintf(stderr, "kernel_launch: unexpected sizes (n_in %d out %d ws %zu need %zu)\n", n_in, out_size, ws_size, m.end); return; }
    P p; memset(&p, 0, sizeof(p)); fill_params(p, d_in, d_out, d_ws, m);
    (void)hipMemsetAsync((char*)d_ws + m.cnt, 0, CTL_BYTES, stream);
#if 1
    static int grid = 0;
    if (grid == 0) {
        int dev = 0, cus = 0, per_cu = 0;
        if (hipGetDevice(&dev) != hipSuccess || hipDeviceGetAttribute(&cus, hipDeviceAttributeMultiprocessorCount, dev) != hipSuccess) { fprintf(stderr, "kernel_launch: device query failed\n"); grid = -1; return; }
        if (hipFuncSetAttribute((const void*)mk_fwd, hipFuncAttributeMaxDynamicSharedMemorySize, LDS_BYTES) != hipSuccess) { fprintf(stderr, "kernel_launch: hipFuncSetAttribute failed\n"); grid = -1; return; }
        if (hipOccupancyMaxActiveBlocksPerMultiprocessor(&per_cu, (const void*)mk_fwd, 512, LDS_BYTES) != hipSuccess || per_cu < 1) { fprintf(stderr, "kernel_launch: occupancy query says %d blocks per CU\n", per_cu); }
        (void)hipGetLastError();
        grid = cus;
        if (grid != 256) { fprintf(stderr, "kernel_launch: built for 256 CUs, device has %d; nothing launched\n", cus); grid = -1; return; }
    }
    if (grid < 0) return;
    hipLaunchKernelGGL(mk_fwd, dim3(grid), dim3(512), LDS_BYTES, stream, p);
#endif
}
#endif
```
